# Optimizing an MI355X kernel written in HIP

```python
import jax, jax.numpy as jnp
from jax import lax
import numpy as np

D_MODEL = 2048
BATCH = 4
SEQ = 4096
DEPTH = 1

MIX_WIDTH = D_MODEL
POOL_WINDOWS = (2, 4, 8, 16)
N_POOL_GROUPS = len(POOL_WINDOWS)
POOL_WIDTH = MIX_WIDTH // 2
POOL_GROUP_DIM = POOL_WIDTH // N_POOL_GROUPS
FOURIER_WIDTH = MIX_WIDTH - POOL_WIDTH
N_FOURIER_HEADS = 4
FOURIER_HEAD_DIM = FOURIER_WIDTH // N_FOURIER_HEADS
N_EXPERT_GROUPS = 4
EXPERTS_PER_GROUP = 4
N_EXPERTS = N_EXPERT_GROUPS * EXPERTS_PER_GROUP
TOP_K_IN_GROUP = 2
EXPERT_FF = D_MODEL // 4
RMS_EPS = 1e-6

kernel_name = "hybrid_pool_fourier_hmoe_block"


def _rmsnorm(x, g):
    xf = x.astype(jnp.float32)
    y = xf * lax.rsqrt(jnp.mean(xf * xf, axis=-1, keepdims=True) + RMS_EPS)
    return (y * g.astype(jnp.float32)).astype(x.dtype)


def _multiscale_pool_minus_token(u):
    s_len = u.shape[1]
    uf = u.astype(jnp.float32)
    c = jnp.cumsum(uf, axis=1)
    c = jnp.pad(c, ((0, 0), (1, 0), (0, 0), (0, 0)))
    t = np.arange(s_len)[:, None]
    k = np.array(POOL_WINDOWS)[None, :]
    lo = np.clip(t - (k - 1) // 2, 0, s_len)
    hi = np.clip(t + k // 2 + 1, 0, s_len)
    gid = np.arange(len(POOL_WINDOWS))[None, :]
    window_sum = c[:, hi, gid, :] - c[:, lo, gid, :]
    count = jnp.asarray((hi - lo).astype(np.float32))[None, :, :, None]
    return window_sum / count - uf


def _fourier_real(u):
    f = jnp.fft.fft2(u.astype(jnp.float32), axes=(1, 3), norm="ortho")
    return jnp.real(f)


def _hier_moe(h, w_group_router, b_group_router, w_expert_router, b_expert_router,
              w_gate, w_up, w_down):
    b, s, d = h.shape
    hf = h.reshape(b * s, d)
    g_logits = jnp.dot(hf, w_group_router).astype(jnp.float32) + b_group_router.astype(jnp.float32)
    g_probs = jax.nn.softmax(g_logits, axis=-1)
    p_g, g_idx = lax.top_k(g_probs, 1)
    e_logits = jnp.dot(hf, w_expert_router).astype(jnp.float32) + b_expert_router.astype(jnp.float32)
    e_logits = e_logits.reshape(-1, N_EXPERT_GROUPS, EXPERTS_PER_GROUP)
    e_sel = jnp.take_along_axis(e_logits, g_idx[:, :, None], axis=1)[:, 0]
    top_v, top_i = lax.top_k(e_sel, TOP_K_IN_GROUP)
    w_pair = p_g * jax.nn.softmax(top_v, axis=-1)
    expert_ids = g_idx * EXPERTS_PER_GROUP + top_i
    combine = jnp.sum(jax.nn.one_hot(expert_ids, N_EXPERTS, dtype=jnp.float32)
                      * w_pair[..., None], axis=1).astype(h.dtype)
    a = jnp.einsum('nd,edf->nef', hf, w_gate)
    v = jnp.einsum('nd,edf->nef', hf, w_up)
    act = jax.nn.silu(a) * v * combine[:, :, None]
    out = jnp.einsum('nef,efd->nd', act, w_down)
    return out.reshape(b, s, d)


def setup_inputs(seed: int = 0) -> dict:
    key = jax.random.key(seed)
    ks = jax.random.split(key, 20)
    f32 = jnp.float32
    nrm = lambda k, shp, fan: jax.random.normal(k, shp, f32) * (fan ** -0.5)
    return {
        "x": jax.random.normal(ks[0], (BATCH, SEQ, D_MODEL), f32),
        "g_mix": 1.0 + 0.02 * jax.random.normal(ks[1], (D_MODEL,), f32),
        "w_in": nrm(ks[2], (D_MODEL, MIX_WIDTH), D_MODEL),
        "w_pool": nrm(ks[3], (N_POOL_GROUPS, POOL_GROUP_DIM, POOL_GROUP_DIM), POOL_GROUP_DIM),
        "pool_scale": 1.0 + 0.02 * jax.random.normal(ks[4], (POOL_WIDTH,), f32),
        "w_fourier": nrm(ks[5], (N_FOURIER_HEADS, FOURIER_HEAD_DIM, FOURIER_HEAD_DIM), FOURIER_HEAD_DIM),
        "w_out": nrm(ks[6], (MIX_WIDTH, D_MODEL), MIX_WIDTH),
        "g_ffn": 1.0 + 0.02 * jax.random.normal(ks[7], (D_MODEL,), f32),
        "w_group_router": nrm(ks[8], (D_MODEL, N_EXPERT_GROUPS), D_MODEL),
        "b_group_router": 0.01 * jax.random.normal(ks[9], (N_EXPERT_GROUPS,), f32),
        "w_expert_router": nrm(ks[10], (D_MODEL, N_EXPERTS), D_MODEL),
        "b_expert_router": 0.01 * jax.random.normal(ks[11], (N_EXPERTS,), f32),
        "w_gate": nrm(ks[12], (N_EXPERTS, D_MODEL, EXPERT_FF), D_MODEL),
        "w_up": nrm(ks[13], (N_EXPERTS, D_MODEL, EXPERT_FF), D_MODEL),
        "w_down": nrm(ks[14], (N_EXPERTS, EXPERT_FF, D_MODEL), EXPERT_FF),
        "g_final": 1.0 + 0.02 * jax.random.normal(ks[15], (D_MODEL,), f32),
    }


def reference(x, g_mix, w_in, w_pool, pool_scale, w_fourier, w_out, g_ffn,
              w_group_router, b_group_router, w_expert_router, b_expert_router,
              w_gate, w_up, w_down, g_final):
    b, s, _ = x.shape
    for _layer in range(DEPTH):
        h = _rmsnorm(x, g_mix)
        u = jnp.dot(h, w_in)
        u_pool = u[..., :POOL_WIDTH].reshape(b, s, N_POOL_GROUPS, POOL_GROUP_DIM)
        u_four = u[..., POOL_WIDTH:].reshape(b, s, N_FOURIER_HEADS, FOURIER_HEAD_DIM)
        p = _multiscale_pool_minus_token(u_pool).astype(x.dtype)
        p = jnp.einsum('bsgc,gce->bsge', p, w_pool).reshape(b, s, POOL_WIDTH) * pool_scale
        f = _fourier_real(u_four).astype(x.dtype)
        f = jnp.einsum('bshd,hde->bshe', f, w_fourier).reshape(b, s, FOURIER_WIDTH)
        mixed = jnp.concatenate([p, f], axis=-1)
        x = x + jnp.dot(mixed, w_out)
        h2 = _rmsnorm(x, g_ffn)
        x = x + _hier_moe(h2, w_group_router, b_group_router, w_expert_router,
                          b_expert_router, w_gate, w_up, w_down)
    return _rmsnorm(x, g_final)
```

```cpp
#include <hip/hip_runtime.h>
#include <stdint.h>
#include <stdio.h>

typedef unsigned short bf16_t;
typedef short bf16x8 __attribute__((ext_vector_type(8)));
typedef float f32x4 __attribute__((ext_vector_type(4)));

constexpr int D = 2048, BATCH = 4, SEQ = 4096, NTOK = BATCH * SEQ;
constexpr int PW = 1024, FW = 1024, GD = 256, NE = 16, FF = 512;
constexpr float EPS = 1e-6f;

__device__ __forceinline__ bf16_t f2bf(float f) { unsigned u = __float_as_uint(f); u += 0x7fffu + ((u >> 16) & 1u); return (bf16_t)(u >> 16); }
__device__ __forceinline__ float wave_sum(float v) {
#pragma unroll
    for (int o = 1; o < 64; o <<= 1) v += __shfl_xor(v, o);
    return v;
}

template <class AL, class BL, class EP>
__global__ __launch_bounds__(256) void gemm_k(AL al, BL bl, EP ep, long Kl) {
    const int K = (int)Kl;
    __shared__ __attribute__((aligned(16))) bf16_t As[128][40];
    __shared__ __attribute__((aligned(16))) bf16_t Bs[128][40];
    const int tid = threadIdx.x, wid = tid >> 6, lane = tid & 63;
    const int bm = blockIdx.y * 128, bn = blockIdx.x * 128, bz = blockIdx.z;
    if (!al.active(bz, bm)) return;
    const int wr = wid >> 1, wc = wid & 1;
    f32x4 acc[4][4];
#pragma unroll
    for (int m = 0; m < 4; ++m)
#pragma unroll
        for (int n = 0; n < 4; ++n) acc[m][n] = (f32x4){0.f, 0.f, 0.f, 0.f};
    for (int k0 = 0; k0 < K; k0 += 32) {
#pragma unroll
        for (int i = 0; i < 4; ++i) {
            const int row = (tid >> 3) + 32 * i, kk = (tid & 7) * 4;
            const float4 v = al.load4(bz, bm + row, k0 + kk);
            As[row][kk + 0] = f2bf(v.x); As[row][kk + 1] = f2bf(v.y); As[row][kk + 2] = f2bf(v.z); As[row][kk + 3] = f2bf(v.w);
        }
#pragma unroll
        for (int i = 0; i < 4; ++i) {
            const int k = (tid >> 5) + 8 * i, n = (tid & 31) * 4;
            const float4 v = bl.load4(bz, k0 + k, bn + n, n);
            Bs[n + 0][k] = f2bf(v.x); Bs[n + 1][k] = f2bf(v.y); Bs[n + 2][k] = f2bf(v.z); Bs[n + 3][k] = f2bf(v.w);
        }
        __syncthreads();
        bf16x8 a[4], b[4];
#pragma unroll
        for (int m = 0; m < 4; ++m) a[m] = *(const bf16x8*)&As[wr * 64 + m * 16 + (lane & 15)][(lane >> 4) * 8];
#pragma unroll
        for (int n = 0; n < 4; ++n) b[n] = *(const bf16x8*)&Bs[wc * 64 + n * 16 + (lane & 15)][(lane >> 4) * 8];
#pragma unroll
        for (int m = 0; m < 4; ++m)
#pragma unroll
            for (int n = 0; n < 4; ++n) acc[m][n] = __builtin_amdgcn_mfma_f32_16x16x32_bf16(a[m], b[n], acc[m][n], 0, 0, 0);
        __syncthreads();
    }
    ep(bz, bm, bn, wr, wc, lane, acc);
}

struct LdA { const float* p; long ld, zs; long coff_z;
    __device__ bool active(int, int) const { return true; }
    __device__ float4 load4(int z, int r, int c) const { return *(const float4*)(p + (long)z * zs + (long)r * ld + (long)z * coff_z + c); } };
struct LdB { const float* p; long ld, zs; long coff_z;
    __device__ float4 load4(int z, int k, int n, int) const { return *(const float4*)(p + (long)z * zs + (long)k * ld + (long)z * coff_z + n); } };
template <class F> struct EpEl { F f;
    __device__ void operator()(int z, int bm, int bn, int wr, int wc, int lane, const f32x4 (&acc)[4][4]) const {
#pragma unroll
        for (int m = 0; m < 4; ++m)
#pragma unroll
            for (int n = 0; n < 4; ++n)
#pragma unroll
                for (int r = 0; r < 4; ++r) f(z, bm + wr * 64 + m * 16 + (lane >> 4) * 4 + r, bn + wc * 64 + n * 16 + (lane & 15), acc[m][n][r]);
    } };

struct StoreF { float* p; long ld, zs; long coff_z; const float* scale; const float* res;
    __device__ void operator()(int z, int r, int n, float v) const {
        const long o = (long)z * zs + (long)r * ld + (long)z * coff_z + n;
        if (scale) v *= scale[z * coff_z + n];
        if (res) v += res[o];
        p[o] = v; } };

struct LdDftS { const float* ct; const float* st;
    __device__ bool active(int, int) const { return true; }
    __device__ float4 load4(int, int m, int s) const { const int k = m & 4095; const bool im = m >= 4096; float v[4];
#pragma unroll
        for (int j = 0; j < 4; ++j) { const int idx = (k * (s + j)) & 4095; v[j] = im ? -st[idx] : ct[idx]; }
        return make_float4(v[0], v[1], v[2], v[3]); } };
struct StoreY { float* yr; float* yi;
    __device__ void operator()(int z, int m, int n, float v) const { if (m < 4096) yr[((long)z * 4096 + m) * 1024 + n] = v; else yi[((long)z * 4096 + (m - 4096)) * 1024 + n] = v; } };
struct LdYri { const float* yr; const float* yi;
    __device__ bool active(int, int) const { return true; }
    __device__ float4 load4(int z, int r, int c) const { return c < 256 ? *(const float4*)(yr + (long)r * 1024 + z * 256 + c) : *(const float4*)(yi + (long)r * 1024 + z * 256 + c - 256); } };
struct LdDftD { const float* ct; const float* st;
    __device__ float4 load4(int, int k, int n, int) const { const int kk = k & 255; const bool s = k >= 256; float v[4];
#pragma unroll
        for (int j = 0; j < 4; ++j) { const int idx = ((kk * (n + j)) & 255) * 16; v[j] = (s ? st[idx] : ct[idx]) * (1.0f / 1024.0f); }
        return make_float4(v[0], v[1], v[2], v[3]); } };

struct LdGather { const float* p; long ld; const int* list; const int* off; const int* cnt;
    __device__ bool active(int z, int bm) const { return bm < cnt[z]; }
    __device__ float4 load4(int z, int r, int c) const { if (r >= cnt[z]) return make_float4(0.f, 0.f, 0.f, 0.f); const int t = list[off[z] + r]; return *(const float4*)(p + (long)t * ld + c); } };
struct LdRows { const float* p; long ld; const int* off; const int* cnt;
    __device__ bool active(int z, int bm) const { return bm < cnt[z]; }
    __device__ float4 load4(int z, int r, int c) const { if (r >= cnt[z]) return make_float4(0.f, 0.f, 0.f, 0.f); return *(const float4*)(p + (long)(off[z] + r) * ld + c); } };
struct LdGU { const float* wg; const float* wu;
    __device__ float4 load4(int z, int k, int n, int nl) const { const int bn = n - nl, wc = nl >> 6, t = (nl & 63) >> 4, c = nl & 15; const int f = (bn >> 1) + wc * 32 + (t & 1) * 16 + c;
        const float* w = (t < 2) ? wg : wu; return *(const float4*)(w + ((long)z * D + k) * FF + f); } };
struct EpGU { float* act; const int* off; const int* cnt; const float* pw;
    __device__ void operator()(int z, int bm, int bn, int wr, int wc, int lane, const f32x4 (&acc)[4][4]) const {
#pragma unroll
        for (int m = 0; m < 4; ++m)
#pragma unroll
            for (int t = 0; t < 2; ++t)
#pragma unroll
                for (int r = 0; r < 4; ++r) { const int row = bm + wr * 64 + m * 16 + (lane >> 4) * 4 + r; if (row >= cnt[z]) continue;
                    const int f = (bn >> 1) + wc * 32 + t * 16 + (lane & 15); const float g = acc[m][t][r], u = acc[m][t + 2][r];
                    const long pos = off[z] + row; act[pos * FF + f] = g / (1.f + __expf(-g)) * u * pw[pos]; }
    } };
struct EpDown { float* yd; const int* off; const int* cnt;
    __device__ void operator()(int z, int bm, int bn, int wr, int wc, int lane, const f32x4 (&acc)[4][4]) const {
#pragma unroll
        for (int m = 0; m < 4; ++m)
#pragma unroll
            for (int n = 0; n < 4; ++n)
#pragma unroll
                for (int r = 0; r < 4; ++r) { const int row = bm + wr * 64 + m * 16 + (lane >> 4) * 4 + r; if (row >= cnt[z]) continue;
                    yd[(long)(off[z] + row) * D + bn + wc * 64 + n * 16 + (lane & 15)] = acc[m][n][r]; }
    } };

__global__ void k_tables(float* ct, float* st, int* cnt) {
    const int i = blockIdx.x * blockDim.x + threadIdx.x;
    if (i < 4096) { ct[i] = cospif((float)i / 2048.0f); st[i] = sinpif((float)i / 2048.0f); }
    if (i < 64) cnt[i] = 0;
}
__global__ __launch_bounds__(256) void k_rmsnorm(const float* x, const float* g, float* out, const float* yd, const int* tpos) {
    const int row = blockIdx.x * 4 + (threadIdx.x >> 6), lane = threadIdx.x & 63;
    const f32x4* xr = (const f32x4*)(x + (long)row * D) + lane;
    f32x4 v[8]; float s = 0.f;
#pragma unroll
    for (int j = 0; j < 8; ++j) v[j] = xr[64 * j];
    if (yd) {
        const int p0 = tpos[2 * row], p1 = tpos[2 * row + 1];
        const f32x4* y0 = (const f32x4*)(yd + (long)p0 * D) + lane; const f32x4* y1 = (const f32x4*)(yd + (long)p1 * D) + lane;
#pragma unroll
        for (int j = 0; j < 8; ++j) v[j] = v[j] + (y0[64 * j] + y1[64 * j]);
    }
#pragma unroll
    for (int j = 0; j < 8; ++j) s += (v[j].x * v[j].x + v[j].y * v[j].y) + (v[j].z * v[j].z + v[j].w * v[j].w);
    const float rstd = 1.0f / sqrtf(wave_sum(s) * (1.0f / D) + EPS);
    f32x4* orow = (f32x4*)(out + (long)row * D) + lane; const f32x4* gr = (const f32x4*)g + lane;
#pragma unroll
    for (int j = 0; j < 8; ++j) orow[64 * j] = v[j] * rstd * gr[64 * j];
}
__global__ __launch_bounds__(256) void k_pool(const float* u, float* P) {
    const int idx = blockIdx.x * 256 + threadIdx.x;
    const int tok = idx >> 8, c4 = (idx & 255) * 4, g = c4 >> 8;
    const int b = tok / SEQ, t = tok % SEQ, k = 2 << g;
    int lo = t - (k - 1) / 2, hi = t + k / 2 + 1; lo = lo < 0 ? 0 : lo; hi = hi > SEQ ? SEQ : hi;
    f32x4 s = (f32x4){0.f, 0.f, 0.f, 0.f};
    for (int tt = lo; tt < hi; ++tt) s += *(const f32x4*)(u + ((long)(b * SEQ + tt)) * D + c4);
    const f32x4 self = *(const f32x4*)(u + (long)tok * D + c4);
    *(f32x4*)(P + (long)tok * PW + c4) = s * (1.0f / (float)(hi - lo)) - self;
}
__global__ __launch_bounds__(256) void k_router(const float* h2, const float* wgr, const float* bgr, const float* wer, const float* ber, int* tok_e, float* tok_w, int* cnt) {
    const int row = blockIdx.x * 4 + (threadIdx.x >> 6), lane = threadIdx.x & 63;
    float acc[20];
#pragma unroll
    for (int j = 0; j < 20; ++j) acc[j] = 0.f;
    for (int i = 0; i < 32; ++i) {
        const int d = i * 64 + lane; const float hv = h2[(long)row * D + d];
        const f32x4 wg = *(const f32x4*)(wgr + d * 4);
        acc[0] += hv * wg.x; acc[1] += hv * wg.y; acc[2] += hv * wg.z; acc[3] += hv * wg.w;
#pragma unroll
        for (int q = 0; q < 4; ++q) { const f32x4 we = *(const f32x4*)(wer + d * 16 + q * 4);
            acc[4 + q * 4 + 0] += hv * we.x; acc[4 + q * 4 + 1] += hv * we.y; acc[4 + q * 4 + 2] += hv * we.z; acc[4 + q * 4 + 3] += hv * we.w; }
    }
#pragma unroll
    for (int j = 0; j < 20; ++j) acc[j] = wave_sum(acc[j]);
    if (lane == 0) {
        float gl[4]; int gi = 0; float mx = -3.0e38f;
#pragma unroll
        for (int j = 0; j < 4; ++j) { gl[j] = acc[j] + bgr[j]; if (gl[j] > mx) { mx = gl[j]; gi = j; } }
        float se = 0.f;
#pragma unroll
        for (int j = 0; j < 4; ++j) se += __expf(gl[j] - mx);
        const float pg = 1.0f / se;
        float el[4];
#pragma unroll
        for (int j = 0; j < 4; ++j) { float v = 0.f;
#pragma unroll
            for (int q = 0; q < 4; ++q) v = (gi == q) ? acc[4 + q * 4 + j] + ber[q * 4 + j] : v;
            el[j] = v; }
        int i0 = 0; float v0 = el[0];
#pragma unroll
        for (int j = 1; j < 4; ++j) if (el[j] > v0) { v0 = el[j]; i0 = j; }
        int i1 = -1; float v1 = -3.0e38f;
#pragma unroll
        for (int j = 0; j < 4; ++j) if (j != i0 && el[j] > v1) { v1 = el[j]; i1 = j; }
        const float e1 = __expf(v1 - v0), inv = 1.0f / (1.0f + e1);
        const int ea = gi * 4 + i0, eb = gi * 4 + i1;
        tok_e[2 * row] = ea; tok_e[2 * row + 1] = eb; tok_w[2 * row] = pg * inv; tok_w[2 * row + 1] = pg * e1 * inv;
        atomicAdd(&cnt[ea], 1); atomicAdd(&cnt[eb], 1);
    }
}
__global__ void k_offsets(const int* cnt, int* off, int* cur) { if (threadIdx.x == 0) { int s = 0; for (int e = 0; e < NE; ++e) { off[e] = s; cur[e] = 0; s += cnt[e]; } } }
__global__ void k_fill(const int* tok_e, const float* tok_w, const int* off, int* cur, int* list, int* tpos, float* pw) {
    const int i = blockIdx.x * blockDim.x + threadIdx.x; if (i >= 2 * NTOK) return;
    const int e = tok_e[i]; const int pos = off[e] + atomicAdd(&cur[e], 1);
    list[pos] = i >> 1; tpos[i] = pos; pw[pos] = tok_w[i];
}

extern "C" void kernel_launch(void* const* d_in, const int* in_sizes, int n_in, void* d_out, int out_size, void* d_ws, size_t ws_size, hipStream_t stream) {
    const float* x = (const float*)d_in[0]; const float* g_mix = (const float*)d_in[1]; const float* w_in = (const float*)d_in[2];
    const float* w_pool = (const float*)d_in[3]; const float* pool_scale = (const float*)d_in[4]; const float* w_fourier = (const float*)d_in[5];
    const float* w_out = (const float*)d_in[6]; const float* g_ffn = (const float*)d_in[7]; const float* wgr = (const float*)d_in[8];
    const float* bgr = (const float*)d_in[9]; const float* wer = (const float*)d_in[10]; const float* ber = (const float*)d_in[11];
    const float* w_gate = (const float*)d_in[12]; const float* w_up = (const float*)d_in[13]; const float* w_down = (const float*)d_in[14];
    const float* g_final = (const float*)d_in[15];
    float* out = (float*)d_out; char* ws = (char*)d_ws;
    constexpr size_t MiB = 1u << 20;
    float* H = (float*)(ws + 0 * MiB);
    float* U = (float*)(ws + 128 * MiB);
    float* MIX = U;
    float* YR = (float*)(ws + 256 * MiB);
    float* YI = (float*)(ws + 320 * MiB);
    float* P = (float*)(ws + 384 * MiB);
    float* FR = P;
    float* YD = (float*)(ws + 128 * MiB);
    float* ACT = (float*)(ws + 400 * MiB);
    char* sm = ws + 480 * MiB;
    float* ct = (float*)(sm); float* st = (float*)(sm + 16384);
    int* cnt = (int*)(sm + 32768); int* off = cnt + 64; int* cur = cnt + 128;
    int* tok_e = (int*)(sm + 65536); float* tok_w = (float*)(sm + 65536 + 131072);
    int* list = (int*)(sm + 65536 + 2 * 131072); int* tpos = (int*)(sm + 65536 + 3 * 131072); float* pw = (float*)(sm + 65536 + 4 * 131072);
    if (ws_size < 512 * MiB) { fprintf(stderr, "workspace too small\n"); return; }

    k_tables<<<16, 256, 0, stream>>>(ct, st, cnt);
    k_rmsnorm<<<NTOK / 4, 256, 0, stream>>>(x, g_mix, H, nullptr, nullptr);
    { LdA a{H, D, 0, 0}; LdB b{w_in, D, 0, 0}; EpEl<StoreF> e{{U, D, 0, 0, nullptr, nullptr}};
      gemm_k<<<dim3(D / 128, NTOK / 128, 1), 256, 0, stream>>>(a, b, e, D); }
    k_pool<<<NTOK, 256, 0, stream>>>(U, P);
    { LdDftS a{ct, st}; LdB b{U + 1024, D, (long)SEQ * D, 0}; EpEl<StoreY> e{{YR, YI}};
      gemm_k<<<dim3(FW / 128, 8192 / 128, BATCH), 256, 0, stream>>>(a, b, e, SEQ); }
    { LdA a{P, PW, 0, GD}; LdB b{w_pool, GD, (long)GD * GD, 0}; EpEl<StoreF> e{{MIX, D, 0, GD, pool_scale, nullptr}};
      gemm_k<<<dim3(GD / 128, NTOK / 128, 4), 256, 0, stream>>>(a, b, e, GD); }
    { LdYri a{YR, YI}; LdDftD b{ct, st}; EpEl<StoreF> e{{FR, FW, 0, GD, nullptr, nullptr}};
      gemm_k<<<dim3(GD / 128, NTOK / 128, 4), 256, 0, stream>>>(a, b, e, 512); }
    { LdA a{FR, FW, 0, GD}; LdB b{w_fourier, GD, (long)GD * GD, 0}; EpEl<StoreF> e{{MIX + 1024, D, 0, GD, nullptr, nullptr}};
      gemm_k<<<dim3(GD / 128, NTOK / 128, 4), 256, 0, stream>>>(a, b, e, GD); }
    { LdA a{MIX, D, 0, 0}; LdB b{w_out, D, 0, 0}; EpEl<StoreF> e{{out, D, 0, 0, nullptr, x}};
      gemm_k<<<dim3(D / 128, NTOK / 128, 1), 256, 0, stream>>>(a, b, e, D); }
    k_rmsnorm<<<NTOK / 4, 256, 0, stream>>>(out, g_ffn, H, nullptr, nullptr);
    k_router<<<NTOK / 4, 256, 0, stream>>>(H, wgr, bgr, wer, ber, tok_e, tok_w, cnt);
    k_offsets<<<1, 64, 0, stream>>>(cnt, off, cur);
    k_fill<<<2 * NTOK / 256, 256, 0, stream>>>(tok_e, tok_w, off, cur, list, tpos, pw);
    { LdGather a{H, D, list, off, cnt}; LdGU b{w_gate, w_up}; EpGU e{ACT, off, cnt, pw};
      gemm_k<<<dim3(2 * FF / 128, NTOK / 128, NE), 256, 0, stream>>>(a, b, e, D); }
    { LdRows a{ACT, FF, off, cnt}; LdB b{w_down, D, (long)FF * D, 0}; EpDown e{YD, off, cnt};
      gemm_k<<<dim3(D / 128, NTOK / 128, NE), 256, 0, stream>>>(a, b, e, FF); }
    k_rmsnorm<<<NTOK / 4, 256, 0, stream>>>(out, g_final, out, YD, tpos);
}
```

```cpp
#include <hip/hip_runtime.h>
#include <stdint.h>
#include <stdio.h>
#include <hip/hip_cooperative_groups.h>
namespace cg = cooperative_groups;

typedef unsigned short bf16_t;
typedef short bf16x8 __attribute__((ext_vector_type(8)));
typedef float f32x4 __attribute__((ext_vector_type(4)));

constexpr int D = 2048, BATCH = 4, SEQ = 4096, NTOK = BATCH * SEQ;
constexpr int PW = 1024, FW = 1024, GD = 256, NE = 16, FF = 512;
constexpr float EPS = 1e-6f;

__device__ __forceinline__ bf16_t f2bf(float f) { unsigned u = __float_as_uint(f); u += 0x7fffu + ((u >> 16) & 1u); return (bf16_t)(u >> 16); }
__device__ __forceinline__ float wave_sum(float v) {
#pragma unroll
    for (int o = 1; o < 64; o <<= 1) v += __shfl_xor(v, o);
    return v;
}

template <class AL, class BL, class EP>
__device__ __forceinline__ void gemm_tile(const AL& al, const BL& bl, const EP& ep, const int K, const int bxi, const int byi, const int bz, bf16_t (*As)[40], bf16_t (*Bs)[40]) {
    const int tid = threadIdx.x, wid = tid >> 6, lane = tid & 63;
    const int bm = byi * 128, bn = bxi * 128;
    const int wr = wid >> 1, wc = wid & 1;
    f32x4 acc[4][4];
#pragma unroll
    for (int m = 0; m < 4; ++m)
#pragma unroll
        for (int n = 0; n < 4; ++n) acc[m][n] = (f32x4){0.f, 0.f, 0.f, 0.f};
    for (int k0 = 0; k0 < K; k0 += 32) {
#pragma unroll
        for (int i = 0; i < 4; ++i) {
            const int row = (tid >> 3) + 32 * i, kk = (tid & 7) * 4;
            const float4 v = al.load4(bz, bm + row, k0 + kk);
            As[row][kk + 0] = f2bf(v.x); As[row][kk + 1] = f2bf(v.y); As[row][kk + 2] = f2bf(v.z); As[row][kk + 3] = f2bf(v.w);
        }
#pragma unroll
        for (int i = 0; i < 4; ++i) {
            const int k = (tid >> 5) + 8 * i, n = (tid & 31) * 4;
            const float4 v = bl.load4(bz, k0 + k, bn + n, n);
            Bs[n + 0][k] = f2bf(v.x); Bs[n + 1][k] = f2bf(v.y); Bs[n + 2][k] = f2bf(v.z); Bs[n + 3][k] = f2bf(v.w);
        }
        __syncthreads();
        bf16x8 a[4], b[4];
#pragma unroll
        for (int m = 0; m < 4; ++m) a[m] = *(const bf16x8*)&As[wr * 64 + m * 16 + (lane & 15)][(lane >> 4) * 8];
#pragma unroll
        for (int n = 0; n < 4; ++n) b[n] = *(const bf16x8*)&Bs[wc * 64 + n * 16 + (lane & 15)][(lane >> 4) * 8];
#pragma unroll
        for (int m = 0; m < 4; ++m)
#pragma unroll
            for (int n = 0; n < 4; ++n) acc[m][n] = __builtin_amdgcn_mfma_f32_16x16x32_bf16(a[m], b[n], acc[m][n], 0, 0, 0);
        __syncthreads();
    }
    ep(bz, bm, bn, wr, wc, lane, acc);
}
template <class AL, class BL, class EP>
__device__ __forceinline__ void gemm_phase(const AL& al, const BL& bl, const EP& ep, int K, int nx, int ny, int nz, bf16_t (*As)[40], bf16_t (*Bs)[40]) {
    const int total = nx * ny * nz;
    for (int t = blockIdx.x; t < total; t += gridDim.x) {
        const int bxi = t % nx, byi = (t / nx) % ny, bz = t / (nx * ny);
        if (!al.active(bz, byi * 128)) continue;
        gemm_tile(al, bl, ep, K, bxi, byi, bz, As, Bs);
    }
}

struct LdA { const float* p; long ld, zs; long coff_z;
    __device__ bool active(int, int) const { return true; }
    __device__ float4 load4(int z, int r, int c) const { return *(const float4*)(p + (long)z * zs + (long)r * ld + (long)z * coff_z + c); } };
struct LdB { const float* p; long ld, zs; long coff_z;
    __device__ float4 load4(int z, int k, int n, int) const { return *(const float4*)(p + (long)z * zs + (long)k * ld + (long)z * coff_z + n); } };
template <class F> struct EpEl { F f;
    __device__ void operator()(int z, int bm, int bn, int wr, int wc, int lane, const f32x4 (&acc)[4][4]) const {
#pragma unroll
        for (int m = 0; m < 4; ++m)
#pragma unroll
            for (int n = 0; n < 4; ++n)
#pragma unroll
                for (int r = 0; r < 4; ++r) f(z, bm + wr * 64 + m * 16 + (lane >> 4) * 4 + r, bn + wc * 64 + n * 16 + (lane & 15), acc[m][n][r]);
    } };

struct StoreF { float* p; long ld, zs; long coff_z; const float* scale; const float* res;
    __device__ void operator()(int z, int r, int n, float v) const {
        const long o = (long)z * zs + (long)r * ld + (long)z * coff_z + n;
        if (scale) v *= scale[z * coff_z + n];
        if (res) v += res[o];
        p[o] = v; } };

struct LdDftS { const float* ct; const float* st;
    __device__ bool active(int, int) const { return true; }
    __device__ float4 load4(int, int m, int s) const { const int k = m & 4095; const bool im = m >= 4096; float v[4];
#pragma unroll
        for (int j = 0; j < 4; ++j) { const int idx = (k * (s + j)) & 4095; v[j] = im ? -st[idx] : ct[idx]; }
        return make_float4(v[0], v[1], v[2], v[3]); } };
struct StoreY { float* yr; float* yi;
    __device__ void operator()(int z, int m, int n, float v) const { if (m < 4096) yr[((long)z * 4096 + m) * 1024 + n] = v; else yi[((long)z * 4096 + (m - 4096)) * 1024 + n] = v; } };
struct LdYri { const float* yr; const float* yi;
    __device__ bool active(int, int) const { return true; }
    __device__ float4 load4(int z, int r, int c) const { return c < 256 ? *(const float4*)(yr + (long)r * 1024 + z * 256 + c) : *(const float4*)(yi + (long)r * 1024 + z * 256 + c - 256); } };
struct LdDftD { const float* ct; const float* st;
    __device__ float4 load4(int, int k, int n, int) const { const int kk = k & 255; const bool s = k >= 256; float v[4];
#pragma unroll
        for (int j = 0; j < 4; ++j) { const int idx = ((kk * (n + j)) & 255) * 16; v[j] = (s ? st[idx] : ct[idx]) * (1.0f / 1024.0f); }
        return make_float4(v[0], v[1], v[2], v[3]); } };

struct LdGather { const float* p; long ld; const int* list; const int* off; const int* cnt;
    __device__ bool active(int z, int bm) const { return bm < cnt[z]; }
    __device__ float4 load4(int z, int r, int c) const { const bool ok = r < cnt[z]; const int t = list[off[z] + (ok ? r : 0)]; float4 v = *(const float4*)(p + (long)t * ld + c); const float m = ok ? 1.f : 0.f; v.x *= m; v.y *= m; v.z *= m; v.w *= m; return v; } };
struct LdRows { const float* p; long ld; const int* off; const int* cnt;
    __device__ bool active(int z, int bm) const { return bm < cnt[z]; }
    __device__ float4 load4(int z, int r, int c) const { const bool ok = r < cnt[z]; float4 v = *(const float4*)(p + (long)(off[z] + (ok ? r : 0)) * ld + c); const float m = ok ? 1.f : 0.f; v.x *= m; v.y *= m; v.z *= m; v.w *= m; return v; } };
struct LdGU { const float* wg; const float* wu;
    __device__ float4 load4(int z, int k, int n, int nl) const { const int bn = n - nl, wc = nl >> 6, t = (nl & 63) >> 4, c = nl & 15; const int f = (bn >> 1) + wc * 32 + (t & 1) * 16 + c;
        const long delta = (t < 2) ? 0l : (long)(wu - wg); return *(const float4*)(wg + delta + ((long)z * D + k) * FF + f); } };
struct EpGU { float* act; const int* off; const int* cnt; const float* pw;
    __device__ void operator()(int z, int bm, int bn, int wr, int wc, int lane, const f32x4 (&acc)[4][4]) const {
#pragma unroll
        for (int m = 0; m < 4; ++m)
#pragma unroll
            for (int t = 0; t < 2; ++t)
#pragma unroll
                for (int r = 0; r < 4; ++r) { const int row = bm + wr * 64 + m * 16 + (lane >> 4) * 4 + r; if (row >= cnt[z]) continue;
                    const int f = (bn >> 1) + wc * 32 + t * 16 + (lane & 15); const float g = acc[m][t][r], u = acc[m][t + 2][r];
                    const long pos = off[z] + row; act[pos * FF + f] = g / (1.f + __expf(-g)) * u * pw[pos]; }
    } };
struct EpDown { float* yd; const int* off; const int* cnt;
    __device__ void operator()(int z, int bm, int bn, int wr, int wc, int lane, const f32x4 (&acc)[4][4]) const {
#pragma unroll
        for (int m = 0; m < 4; ++m)
#pragma unroll
            for (int n = 0; n < 4; ++n)
#pragma unroll
                for (int r = 0; r < 4; ++r) { const int row = bm + wr * 64 + m * 16 + (lane >> 4) * 4 + r; if (row >= cnt[z]) continue;
                    yd[(long)(off[z] + row) * D + bn + wc * 64 + n * 16 + (lane & 15)] = acc[m][n][r]; }
    } };

struct Params {
    const float *x, *g_mix, *w_in, *w_pool, *pool_scale, *w_fourier, *w_out, *g_ffn, *wgr, *bgr, *wer, *ber, *w_gate, *w_up, *w_down, *g_final;
    float* out; char* ws;
};
constexpr size_t MiB = 1u << 20;

__device__ __forceinline__ void rms_row(const float* x, const float* g, float* out, int row, int lane, const float* yd, const int* tpos, f32x4 (&v)[8]) {
    const f32x4* xr = (const f32x4*)(x + (long)row * D) + lane; float s = 0.f;
#pragma unroll
    for (int j = 0; j < 8; ++j) v[j] = xr[64 * j];
    if (yd) {
        const int p0 = tpos[2 * row], p1 = tpos[2 * row + 1];
        const f32x4* y0 = (const f32x4*)(yd + (long)p0 * D) + lane; const f32x4* y1 = (const f32x4*)(yd + (long)p1 * D) + lane;
#pragma unroll
        for (int j = 0; j < 8; ++j) v[j] = v[j] + (y0[64 * j] + y1[64 * j]);
    }
#pragma unroll
    for (int j = 0; j < 8; ++j) s += (v[j].x * v[j].x + v[j].y * v[j].y) + (v[j].z * v[j].z + v[j].w * v[j].w);
    const float rstd = 1.0f / sqrtf(wave_sum(s) * (1.0f / D) + EPS);
    f32x4* orow = (f32x4*)(out + (long)row * D) + lane; const f32x4* gr = (const f32x4*)g + lane;
#pragma unroll
    for (int j = 0; j < 8; ++j) { v[j] = v[j] * rstd * gr[64 * j]; orow[64 * j] = v[j]; }
}
__device__ __forceinline__ void router_row(const f32x4 (&v)[8], int row, int lane, const float* wgr, const float* bgr, const float* wer, const float* ber, int* tok_e, float* tok_w, int* cnt) {
    float acc[20];
#pragma unroll
    for (int j = 0; j < 20; ++j) acc[j] = 0.f;
#pragma unroll
    for (int j = 0; j < 8; ++j)
#pragma unroll
        for (int i = 0; i < 4; ++i) {
            const int d = 256 * j + 4 * lane + i; const float hv = v[j][i];
            const f32x4 wg = *(const f32x4*)(wgr + d * 4);
            acc[0] += hv * wg.x; acc[1] += hv * wg.y; acc[2] += hv * wg.z; acc[3] += hv * wg.w;
#pragma unroll
            for (int q = 0; q < 4; ++q) { const f32x4 we = *(const f32x4*)(wer + d * 16 + q * 4);
                acc[4 + q * 4 + 0] += hv * we.x; acc[4 + q * 4 + 1] += hv * we.y; acc[4 + q * 4 + 2] += hv * we.z; acc[4 + q * 4 + 3] += hv * we.w; }
        }
#pragma unroll
    for (int j = 0; j < 20; ++j) acc[j] = wave_sum(acc[j]);
    if (lane == 0) {
        float gl[4]; int gi = 0; float mx = -3.0e38f;
#pragma unroll
        for (int j = 0; j < 4; ++j) { gl[j] = acc[j] + bgr[j]; if (gl[j] > mx) { mx = gl[j]; gi = j; } }
        float se = 0.f;
#pragma unroll
        for (int j = 0; j < 4; ++j) se += __expf(gl[j] - mx);
        const float pg = 1.0f / se;
        float el[4];
#pragma unroll
        for (int j = 0; j < 4; ++j) { float t = 0.f;
#pragma unroll
            for (int q = 0; q < 4; ++q) t = (gi == q) ? acc[4 + q * 4 + j] + ber[q * 4 + j] : t;
            el[j] = t; }
        int i0 = 0; float v0 = el[0];
#pragma unroll
        for (int j = 1; j < 4; ++j) if (el[j] > v0) { v0 = el[j]; i0 = j; }
        int i1 = -1; float v1 = -3.0e38f;
#pragma unroll
        for (int j = 0; j < 4; ++j) if (j != i0 && el[j] > v1) { v1 = el[j]; i1 = j; }
        const float e1 = __expf(v1 - v0), inv = 1.0f / (1.0f + e1);
        const int ea = gi * 4 + i0, eb = gi * 4 + i1;
        tok_e[2 * row] = ea; tok_e[2 * row + 1] = eb; tok_w[2 * row] = pg * inv; tok_w[2 * row + 1] = pg * e1 * inv;
        atomicAdd(&cnt[ea], 1); atomicAdd(&cnt[eb], 1);
    }
}

__global__ __launch_bounds__(256, 2) void mega(Params p) {
    __shared__ __attribute__((aligned(16))) bf16_t As[128][40];
    __shared__ __attribute__((aligned(16))) bf16_t Bs[128][40];
    cg::grid_group grid = cg::this_grid();
    const int tid = threadIdx.x, lane = tid & 63, wid = tid >> 6;
    const int gthreads = gridDim.x * 256, gtid = blockIdx.x * 256 + tid;
    const int gwaves = gridDim.x * 4, gwave = blockIdx.x * 4 + wid;
    char* ws = p.ws; float* out = p.out;
    float* H = (float*)(ws + 0 * MiB); float* U = (float*)(ws + 128 * MiB); float* MIX = U;
    float* YR = (float*)(ws + 256 * MiB); float* YI = (float*)(ws + 320 * MiB); float* P = (float*)(ws + 384 * MiB); float* FR = P;
    float* YD = (float*)(ws + 128 * MiB); float* ACT = (float*)(ws + 400 * MiB);
    char* sm = ws + 480 * MiB;
    float* ct = (float*)(sm); float* st = (float*)(sm + 16384);
    int* cnt = (int*)(sm + 32768); int* off = cnt + 64; int* cur = cnt + 128;
    int* tok_e = (int*)(sm + 65536); float* tok_w = (float*)(sm + 65536 + 131072);
    int* list = (int*)(sm + 65536 + 2 * 131072); int* tpos = (int*)(sm + 65536 + 3 * 131072); float* pw = (float*)(sm + 65536 + 4 * 131072);
    f32x4 v[8];

    for (int i = gtid; i < 4096; i += gthreads) { ct[i] = cospif((float)i / 2048.0f); st[i] = sinpif((float)i / 2048.0f); }
    if (gtid < 192) cnt[gtid] = 0;
    for (int row = gwave; row < NTOK; row += gwaves) rms_row(p.x, p.g_mix, H, row, lane, nullptr, nullptr, v);
    grid.sync();
    { LdA a{H, D, 0, 0}; LdB b{p.w_in, D, 0, 0}; EpEl<StoreF> e{{U, D, 0, 0, nullptr, nullptr}};
      gemm_phase(a, b, e, D, D / 128, NTOK / 128, 1, As, Bs); }
    grid.sync();
    for (int idx = gtid; idx < NTOK * 256; idx += gthreads) {
        const int tok = idx >> 8, c4 = (idx & 255) * 4, g = c4 >> 8;
        const int b = tok / SEQ, t = tok % SEQ, k = 2 << g;
        int lo = t - (k - 1) / 2, hi = t + k / 2 + 1; lo = lo < 0 ? 0 : lo; hi = hi > SEQ ? SEQ : hi;
        f32x4 s = (f32x4){0.f, 0.f, 0.f, 0.f};
        for (int tt = lo; tt < hi; ++tt) s += *(const f32x4*)(U + ((long)(b * SEQ + tt)) * D + c4);
        const f32x4 self = *(const f32x4*)(U + (long)tok * D + c4);
        *(f32x4*)(P + (long)tok * PW + c4) = s * (1.0f / (float)(hi - lo)) - self;
    }
    { LdDftS a{ct, st}; LdB b{U + 1024, D, (long)SEQ * D, 0}; EpEl<StoreY> e{{YR, YI}};
      gemm_phase(a, b, e, SEQ, FW / 128, 8192 / 128, BATCH, As, Bs); }
    grid.sync();
    { LdA a{P, PW, 0, GD}; LdB b{p.w_pool, GD, (long)GD * GD, 0}; EpEl<StoreF> e{{MIX, D, 0, GD, p.pool_scale, nullptr}};
      gemm_phase(a, b, e, GD, GD / 128, NTOK / 128, 4, As, Bs); }
    grid.sync();
    { LdYri a{YR, YI}; LdDftD b{ct, st}; EpEl<StoreF> e{{FR, FW, 0, GD, nullptr, nullptr}};
      gemm_phase(a, b, e, 512, GD / 128, NTOK / 128, 4, As, Bs); }
    grid.sync();
    { LdA a{FR, FW, 0, GD}; LdB b{p.w_fourier, GD, (long)GD * GD, 0}; EpEl<StoreF> e{{MIX + 1024, D, 0, GD, nullptr, nullptr}};
      gemm_phase(a, b, e, GD, GD / 128, NTOK / 128, 4, As, Bs); }
    grid.sync();
    { LdA a{MIX, D, 0, 0}; LdB b{p.w_out, D, 0, 0}; EpEl<StoreF> e{{out, D, 0, 0, nullptr, p.x}};
      gemm_phase(a, b, e, D, D / 128, NTOK / 128, 1, As, Bs); }
    grid.sync();
    for (int row = gwave; row < NTOK; row += gwaves) { rms_row(out, p.g_ffn, H, row, lane, nullptr, nullptr, v); router_row(v, row, lane, p.wgr, p.bgr, p.wer, p.ber, tok_e, tok_w, cnt); }
    grid.sync();
    { int offl[NE]; int s = 0;
#pragma unroll
      for (int e = 0; e < NE; ++e) { offl[e] = s; s += cnt[e]; }
      if (gtid < NE) { int o = 0; for (int e = 0; e < gtid; ++e) o += cnt[e]; off[gtid] = o; }
      for (int i = gtid; i < 2 * NTOK; i += gthreads) {
          const int e = tok_e[i]; int o = 0;
#pragma unroll
          for (int q = 0; q < NE; ++q) o = (q == e) ? offl[q] : o;
          const int pos = o + atomicAdd(&cur[e], 1);
          list[pos] = i >> 1; tpos[i] = pos; pw[pos] = tok_w[i]; } }
    grid.sync();
    { LdGather a{H, D, list, off, cnt}; LdGU b{p.w_gate, p.w_up}; EpGU e{ACT, off, cnt, pw};
      gemm_phase(a, b, e, D, 2 * FF / 128, NTOK / 128, NE, As, Bs); }
    grid.sync();
    { LdRows a{ACT, FF, off, cnt}; LdB b{p.w_down, D, (long)FF * D, 0}; EpDown e{YD, off, cnt};
      gemm_phase(a, b, e, FF, D / 128, NTOK / 128, NE, As, Bs); }
    grid.sync();
    for (int row = gwave; row < NTOK; row += gwaves) rms_row(out, p.g_final, out, row, lane, YD, tpos, v);
}

extern "C" void kernel_launch(void* const* d_in, const int* in_sizes, int n_in, void* d_out, int out_size, void* d_ws, size_t ws_size, hipStream_t stream) {
    static int grid_blocks = 0;
    if (!grid_blocks) {
        int dev = 0, cus = 0, per_cu = 0;
        (void)hipGetDevice(&dev);
        (void)hipDeviceGetAttribute(&cus, hipDeviceAttributeMultiprocessorCount, dev);
        (void)hipOccupancyMaxActiveBlocksPerMultiprocessor(&per_cu, mega, 256, 0);
        if (per_cu > 2) per_cu = 2;
        grid_blocks = cus * per_cu;
    }
    if (ws_size < 512 * MiB) { fprintf(stderr, "workspace too small\n"); return; }
    Params p{};
    p.x = (const float*)d_in[0]; p.g_mix = (const float*)d_in[1]; p.w_in = (const float*)d_in[2]; p.w_pool = (const float*)d_in[3];
    p.pool_scale = (const float*)d_in[4]; p.w_fourier = (const float*)d_in[5]; p.w_out = (const float*)d_in[6]; p.g_ffn = (const float*)d_in[7];
    p.wgr = (const float*)d_in[8]; p.bgr = (const float*)d_in[9]; p.wer = (const float*)d_in[10]; p.ber = (const float*)d_in[11];
    p.w_gate = (const float*)d_in[12]; p.w_up = (const float*)d_in[13]; p.w_down = (const float*)d_in[14]; p.g_final = (const float*)d_in[15];
    p.out = (float*)d_out; p.ws = (char*)d_ws;
    void* args[] = {&p};
    hipError_t e = hipLaunchCooperativeKernel((void*)mega, dim3(grid_blocks), dim3(256), args, 0, stream);
    if (e != hipSuccess) fprintf(stderr, "cooperative launch failed: %s (grid %d)\n", hipGetErrorString(e), grid_blocks);
}
```

```cpp
#include <hip/hip_runtime.h>
#include <stdint.h>
#include <stdio.h>
#include <hip/hip_cooperative_groups.h>
namespace cg = cooperative_groups;

typedef unsigned short bf16_t;
typedef short bf16x8 __attribute__((ext_vector_type(8)));
typedef float f32x4 __attribute__((ext_vector_type(4)));
typedef unsigned u32x4 __attribute__((ext_vector_type(4)));
typedef unsigned u32x2 __attribute__((ext_vector_type(2)));
#define LAS __attribute__((address_space(3)))

constexpr int D = 2048, BATCH = 4, SEQ = 4096, NTOK = BATCH * SEQ;
constexpr int PW = 1024, FW = 1024, GD = 256, NE = 16, FF = 512;
constexpr float EPS = 1e-6f;
constexpr int NTHR = 512, NWAVE = 8;
constexpr int LDS_BYTES = 147456;
constexpr size_t MiB = 1u << 20;

__device__ __forceinline__ unsigned f2bf(float f) { unsigned u = __float_as_uint(f); return (u + 0x7fffu + ((u >> 16) & 1u)) >> 16; }
__device__ __forceinline__ unsigned pk2(float lo, float hi) { return f2bf(lo) | (f2bf(hi) << 16); }
__device__ __forceinline__ float bf2f(unsigned short b) { return __uint_as_float(((unsigned)b) << 16); }
__device__ __forceinline__ float wave_sum(float v) {
#pragma unroll
    for (int o = 1; o < 64; o <<= 1) v += __shfl_xor(v, o);
    return v;
}

namespace pg8 {
constexpr int BM = 256, BK = 64, HALF = 128, HTB = HALF * BK * 2, STAGE_BYTES = 8 * HTB, NXCD = 8, WGM = 8;
__host__ __device__ __forceinline__ int lds_byte(int r, int c) { const int st = (r >> 4) * 2 + (c >> 5), rr = r & 15, cc = c & 31, ob = rr * 64 + cc * 2; return st * 1024 + (ob ^ (((ob >> 9) & 1) << 5)); }
__host__ __device__ __forceinline__ void stage_rc(int b, int& R, int& C) { const int st = b / 1024, sb = b % 1024, swz = sb ^ (((sb >> 9) & 1) << 5); R = (st >> 1) * 16 + swz / 64; C = (st & 1) * 32 + (swz % 64) / 2; }

struct Unit { int pm, pn, g; };

struct GridOrder {
    int nM, nN, nwg, G, c;
    __device__ void init(int nM_, int nN_, int G_, int c_) { nM = nM_; nN = nN_; nwg = nM * nN; G = G_; c = c_; }
    __device__ bool next(int i, Unit& u) const {
        const long L = (long)i * G + c; if (L >= nwg) return false;
        int wgid = (int)L; { const int q = nwg / NXCD, r = nwg % NXCD, xcd = wgid % NXCD, off = wgid / NXCD; wgid = (xcd < r ? xcd * (q + 1) : r * (q + 1) + (xcd - r) * q) + off; }
        const int nig = WGM * nN, gid = wgid / nig, fm = gid * WGM, gsz = (nM - fm) < WGM ? (nM - fm) : WGM;
        u.pm = fm + ((wgid % nig) % gsz); u.pn = (wgid % nig) / gsz; u.g = 0; return true;
    }
};

template <class P>
__device__ __forceinline__ void gemm_phase(LAS unsigned char* lds, const P& S) {
    const int tid = threadIdx.x, wid = __builtin_amdgcn_readfirstlane(tid >> 6), lane = tid & 63, wr = wid >> 2, wc = wid & 3, fr = lane & 15, fq = lane >> 4;
    const int K = S.K, nt = K / BK;
    int Rp[2], Cp[2]; unsigned voffB[2];
#pragma unroll
    for (int i = 0; i < 2; ++i) { stage_rc(tid * 16 + i * 8192, Rp[i], Cp[i]); voffB[i] = (unsigned)(Rp[i] * K + Cp[i]) * 2u; }
    const size_t kstep = (size_t)(BK * 2);
    const size_t hstepB = (size_t)HALF * K * 2;
    const unsigned ldsw = (unsigned)wid * 1024u;
    const int aoff = lds_byte(wr * 64 + fr, fq * 8), boff = lds_byte(wc * 32 + fr, fq * 8);
#define PG8_SA(b, h) (((b) * 2 + (h)) * HTB)
#define PG8_SB(b, h) ((4 + (b) * 2 + (h)) * HTB)
#define PG8_STAGE(bufoff, gbase, voff) do { _Pragma("unroll") for (int _i = 0; _i < 2; ++_i) \
        __builtin_amdgcn_global_load_lds((const unsigned*)((const char*)(gbase) + (voff)[_i]), (LAS unsigned*)(lds + (bufoff) + ldsw + _i * 8192), 16, 0, 0); } while (0)
#define PG8_LDA(dst, b, h) do { _Pragma("unroll") for (int m = 0; m < 4; ++m) _Pragma("unroll") for (int k = 0; k < 2; ++k) dst[m][k] = *(const LAS bf16x8*)(lds + PG8_SA(b, h) + aoff + m * 2048 + k * 1024); } while (0)
#define PG8_LDB(dst, b, h) do { _Pragma("unroll") for (int n = 0; n < 2; ++n) _Pragma("unroll") for (int k = 0; k < 2; ++k) dst[n][k] = *(const LAS bf16x8*)(lds + PG8_SB(b, h) + boff + n * 2048 + k * 1024); } while (0)
#define PG8_MMA(ai, bj, At, Bt) do { __builtin_amdgcn_s_setprio(1); _Pragma("unroll") for (int m = 0; m < 4; ++m) _Pragma("unroll") for (int n = 0; n < 2; ++n) _Pragma("unroll") for (int k = 0; k < 2; ++k) \
        acc[ai][bj][m][n] = __builtin_amdgcn_mfma_f32_16x16x32_bf16(Bt[n][k], At[m][k], acc[ai][bj][m][n], 0, 0, 0); __builtin_amdgcn_s_setprio(0); } while (0)
#define PG8_WAIT_V(n) asm volatile("s_waitcnt vmcnt(" #n ")" ::: "memory")
#define PG8_WAIT_L(n) asm volatile("s_waitcnt lgkmcnt(" #n ")" ::: "memory")
#define PG8_BAR __builtin_amdgcn_s_barrier()
#define PG8_SCHED __builtin_amdgcn_sched_barrier(0)
    Unit cur, nxt; int ui = 0;
    if (!S.next(0, cur)) return;
    f32x4 acc[2][2][4][2];
#pragma unroll
    for (int a = 0; a < 2; ++a)
#pragma unroll
        for (int b = 0; b < 2; ++b)
#pragma unroll
            for (int m = 0; m < 4; ++m)
#pragma unroll
                for (int n = 0; n < 2; ++n) acc[a][b][m][n] = (f32x4){0.f, 0.f, 0.f, 0.f};
    bf16x8 At[4][2], B0[2][2], B1[2][2];
    const char* const aB = S.a_base();
    unsigned oc0[2], oc1[2];
#pragma unroll
    for (int i = 0; i < 2; ++i) { oc0[i] = S.a_row_off(cur, Rp[i]) + (unsigned)Cp[i] * 2u; oc1[i] = S.a_row_off(cur, HALF + Rp[i]) + (unsigned)Cp[i] * 2u; }
    const char* cB = S.b_tile(cur);
    PG8_STAGE(PG8_SB(0, 0), cB, voffB); PG8_STAGE(PG8_SB(0, 1), cB + hstepB, voffB); PG8_STAGE(PG8_SA(0, 0), aB, oc0); PG8_STAGE(PG8_SA(0, 1), aB, oc1);
    if (wr == 1) PG8_BAR;
    PG8_WAIT_V(2); PG8_BAR;
    PG8_STAGE(PG8_SB(1, 0), cB + kstep, voffB); PG8_STAGE(PG8_SA(1, 0), aB + kstep, oc0); PG8_STAGE(PG8_SB(1, 1), cB + hstepB + kstep, voffB);
    PG8_WAIT_V(6); PG8_BAR;
    for (;;) {
        const bool has_next = S.next(ui + 1, nxt);
        unsigned on0[2], on1[2];
#pragma unroll
        for (int i = 0; i < 2; ++i) { on0[i] = has_next ? S.a_row_off(nxt, Rp[i]) + (unsigned)Cp[i] * 2u : oc0[i]; on1[i] = has_next ? S.a_row_off(nxt, HALF + Rp[i]) + (unsigned)Cp[i] * 2u : oc1[i]; }
        const char* nB = has_next ? S.b_tile(nxt) : cB;
        for (int t = 0; t < nt; t += 2) {
            const bool last = (t == nt - 2);
            const char* a1 = aB + (size_t)(t + 1) * kstep;
            const char* a2 = last ? aB : aB + (size_t)(t + 2) * kstep; const char* b2 = last ? nB : cB + (size_t)(t + 2) * kstep;
            const char* a3 = a2 + kstep; const char* b3 = b2 + kstep;
            unsigned o20[2], o21[2];
#pragma unroll
            for (int i = 0; i < 2; ++i) { o20[i] = last ? on0[i] : oc0[i]; o21[i] = last ? on1[i] : oc1[i]; }
            PG8_LDB(B0, 0, 0); PG8_LDB(B1, 0, 1); PG8_SCHED; PG8_LDA(At, 0, 0); PG8_STAGE(PG8_SA(1, 1), a1, oc1);
            PG8_WAIT_V(8); PG8_WAIT_L(0); PG8_BAR; PG8_MMA(0, 0, At, B0); PG8_MMA(0, 1, At, B1); PG8_BAR; PG8_SCHED;
            PG8_LDA(At, 0, 1); PG8_STAGE(PG8_SB(0, 0), b2, voffB); PG8_STAGE(PG8_SB(0, 1), b2 + hstepB, voffB); PG8_STAGE(PG8_SA(0, 0), a2, o20);
            PG8_WAIT_V(8); PG8_WAIT_L(0); PG8_BAR; PG8_MMA(1, 0, At, B0); PG8_MMA(1, 1, At, B1); PG8_BAR; PG8_SCHED;
            PG8_LDB(B0, 1, 0); PG8_LDB(B1, 1, 1); PG8_SCHED; PG8_LDA(At, 1, 0); PG8_STAGE(PG8_SA(0, 1), a2, o21);
            PG8_WAIT_V(8); PG8_WAIT_L(0); PG8_BAR; PG8_MMA(0, 0, At, B0); PG8_MMA(0, 1, At, B1); PG8_BAR; PG8_SCHED;
            PG8_LDA(At, 1, 1); PG8_STAGE(PG8_SB(1, 0), b3, voffB); PG8_STAGE(PG8_SB(1, 1), b3 + hstepB, voffB); PG8_STAGE(PG8_SA(1, 0), a3, o20);
            PG8_WAIT_V(8); PG8_WAIT_L(0); PG8_BAR; PG8_MMA(1, 0, At, B0); PG8_MMA(1, 1, At, B1); PG8_BAR; PG8_SCHED;
        }
        if (wr == 0) PG8_BAR;
        S.epi(acc, cur, wr, wc, fr, fq);
        if (!has_next) break;
#pragma unroll
        for (int a = 0; a < 2; ++a)
#pragma unroll
            for (int b = 0; b < 2; ++b)
#pragma unroll
                for (int m = 0; m < 4; ++m)
#pragma unroll
                    for (int n = 0; n < 2; ++n) acc[a][b][m][n] = (f32x4){0.f, 0.f, 0.f, 0.f};
        cur = nxt; cB = nB; ++ui;
#pragma unroll
        for (int i = 0; i < 2; ++i) { oc0[i] = on0[i]; oc1[i] = on1[i]; }
        if (wr == 1) PG8_BAR;
    }
    PG8_WAIT_V(0);
    PG8_BAR;
#undef PG8_SA
#undef PG8_SB
#undef PG8_STAGE
#undef PG8_LDA
#undef PG8_LDB
#undef PG8_MMA
#undef PG8_WAIT_V
#undef PG8_WAIT_L
#undef PG8_BAR
#undef PG8_SCHED
}
}

struct PolGemm1 : pg8::GridOrder {
    int K; const bf16_t* A; const bf16_t* Bt; float* C;
    __device__ const char* a_base() const { return (const char*)A; }
    __device__ unsigned a_row_off(const pg8::Unit& u, int r) const { return (unsigned)(u.pm * 256 + r) * (unsigned)(K * 2); }
    __device__ const char* b_tile(const pg8::Unit& u) const { return (const char*)Bt + (size_t)u.pn * 256 * K * 2; }
    __device__ void epi(const f32x4 (&acc)[2][2][4][2], const pg8::Unit& u, int wr, int wc, int fr, int fq) const {
        const int row0 = u.pm * 256 + wr * 64 + fr, col0 = u.pn * 256 + wc * 32 + 4 * fq;
#pragma unroll
        for (int ai = 0; ai < 2; ++ai)
#pragma unroll
            for (int m = 0; m < 4; ++m) { float* rowp = C + (size_t)(row0 + ai * 128 + m * 16) * D + col0;
#pragma unroll
                for (int bj = 0; bj < 2; ++bj)
#pragma unroll
                    for (int n = 0; n < 2; ++n) *(f32x4*)(rowp + bj * 128 + n * 16) = acc[ai][bj][m][n]; }
    }
};
struct PolGemmOut : pg8::GridOrder {
    int K; const bf16_t* A; const bf16_t* Bt; float* C; const float* X;
    __device__ const char* a_base() const { return (const char*)A; }
    __device__ unsigned a_row_off(const pg8::Unit& u, int r) const { return (unsigned)(u.pm * 256 + r) * (unsigned)(K * 2); }
    __device__ const char* b_tile(const pg8::Unit& u) const { return (const char*)Bt + (size_t)u.pn * 256 * K * 2; }
    __device__ void epi(const f32x4 (&acc)[2][2][4][2], const pg8::Unit& u, int wr, int wc, int fr, int fq) const {
        const int row0 = u.pm * 256 + wr * 64 + fr, col0 = u.pn * 256 + wc * 32 + 4 * fq;
#pragma unroll
        for (int ai = 0; ai < 2; ++ai)
#pragma unroll
            for (int m = 0; m < 4; ++m) { const size_t o = (size_t)(row0 + ai * 128 + m * 16) * D + col0;
#pragma unroll
                for (int bj = 0; bj < 2; ++bj)
#pragma unroll
                    for (int n = 0; n < 2; ++n) *(f32x4*)(C + o + bj * 128 + n * 16) = acc[ai][bj][m][n] + *(const f32x4*)(X + o + bj * 128 + n * 16); }
    }
};

typedef bf16_t LAS (*lds_tile_t)[40];
template <class AL, class BL, class EP>
__device__ __forceinline__ void gemm_tile(const AL& al, const BL& bl, const EP& ep, const int K, const int bxi, const int byi, const int bz, lds_tile_t As, lds_tile_t Bs) {
    const int tid = threadIdx.x, wid = tid >> 6, lane = tid & 63;
    const int bm = byi * 256, bn = bxi * 128;
    const int wr = wid >> 1, wc = wid & 1;
    f32x4 acc[4][4];
#pragma unroll
    for (int m = 0; m < 4; ++m)
#pragma unroll
        for (int n = 0; n < 4; ++n) acc[m][n] = (f32x4){0.f, 0.f, 0.f, 0.f};
    for (int k0 = 0; k0 < K; k0 += 32) {
#pragma unroll
        for (int i = 0; i < 4; ++i) {
            const int row = (tid >> 3) + 64 * i, kk = (tid & 7) * 4;
            const float4 v = al.load4(bz, bm + row, k0 + kk);
            *(LAS u32x2*)&As[row][kk] = (u32x2){pk2(v.x, v.y), pk2(v.z, v.w)};
        }
#pragma unroll
        for (int i = 0; i < 2; ++i) {
            const int k = (tid >> 5) + 16 * i, n = (tid & 31) * 4;
            const float4 v = bl.load4(bz, k0 + k, bn + n, n);
            Bs[n + 0][k] = (bf16_t)f2bf(v.x); Bs[n + 1][k] = (bf16_t)f2bf(v.y); Bs[n + 2][k] = (bf16_t)f2bf(v.z); Bs[n + 3][k] = (bf16_t)f2bf(v.w);
        }
        __syncthreads();
        bf16x8 a[4], b[4];
#pragma unroll
        for (int m = 0; m < 4; ++m) a[m] = *(const LAS bf16x8*)&As[wr * 64 + m * 16 + (lane & 15)][(lane >> 4) * 8];
#pragma unroll
        for (int n = 0; n < 4; ++n) b[n] = *(const LAS bf16x8*)&Bs[wc * 64 + n * 16 + (lane & 15)][(lane >> 4) * 8];
#pragma unroll
        for (int m = 0; m < 4; ++m)
#pragma unroll
            for (int n = 0; n < 4; ++n) acc[m][n] = __builtin_amdgcn_mfma_f32_16x16x32_bf16(a[m], b[n], acc[m][n], 0, 0, 0);
        __syncthreads();
    }
    ep(bz, bm, bn, wr, wc, lane, acc);
}
template <class AL, class BL, class EP>
__device__ __forceinline__ void sgemm_phase(const AL& al, const BL& bl, const EP& ep, int K, int nx, int ny, int nz, lds_tile_t As, lds_tile_t Bs) {
    const int total = nx * ny * nz;
    for (int t = blockIdx.x; t < total; t += gridDim.x) {
        const int bxi = t % nx, byi = (t / nx) % ny, bz = t / (nx * ny);
        if (!al.active(bz, byi * 256)) continue;
        gemm_tile(al, bl, ep, K, bxi, byi, bz, As, Bs);
    }
}

struct LdA { const float* p; long ld, zs; long coff_z;
    __device__ bool active(int, int) const { return true; }
    __device__ float4 load4(int z, int r, int c) const { return *(const float4*)(p + (long)z * zs + (long)r * ld + (long)z * coff_z + c); } };
struct LdB { const float* p; long ld, zs; long coff_z;
    __device__ float4 load4(int z, int k, int n, int) const { return *(const float4*)(p + (long)z * zs + (long)k * ld + (long)z * coff_z + n); } };
template <class F> struct EpEl { F f;
    __device__ void operator()(int z, int bm, int bn, int wr, int wc, int lane, const f32x4 (&acc)[4][4]) const {
#pragma unroll
        for (int m = 0; m < 4; ++m)
#pragma unroll
            for (int n = 0; n < 4; ++n)
#pragma unroll
                for (int r = 0; r < 4; ++r) f(z, bm + wr * 64 + m * 16 + (lane >> 4) * 4 + r, bn + wc * 64 + n * 16 + (lane & 15), acc[m][n][r]);
    } };
struct StoreF { float* p; long ld, zs; long coff_z; const float* scale;
    __device__ void operator()(int z, int r, int n, float v) const {
        const long o = (long)z * zs + (long)r * ld + (long)z * coff_z + n;
        if (scale) v *= scale[z * coff_z + n];
        p[o] = v; } };
struct StoreB { bf16_t* p; long ld, zs; long coff_z; const float* scale;
    __device__ void operator()(int z, int r, int n, float v) const {
        const long o = (long)z * zs + (long)r * ld + (long)z * coff_z + n;
        if (scale) v *= scale[z * coff_z + n];
        p[o] = (bf16_t)f2bf(v); } };
struct LdDftS { const float* ct; const float* st;
    __device__ bool active(int, int) const { return true; }
    __device__ float4 load4(int, int m, int s) const { const int k = m & 4095; const bool im = m >= 4096; float v[4];
#pragma unroll
        for (int j = 0; j < 4; ++j) { const int idx = (k * (s + j)) & 4095; v[j] = im ? -st[idx] : ct[idx]; }
        return make_float4(v[0], v[1], v[2], v[3]); } };
struct StoreY { float* yr; float* yi;
    __device__ void operator()(int z, int m, int n, float v) const { if (m < 4096) yr[((long)z * 4096 + m) * 1024 + n] = v; else yi[((long)z * 4096 + (m - 4096)) * 1024 + n] = v; } };
struct LdYri { const float* yr; const float* yi;
    __device__ bool active(int, int) const { return true; }
    __device__ float4 load4(int z, int r, int c) const { return c < 256 ? *(const float4*)(yr + (long)r * 1024 + z * 256 + c) : *(const float4*)(yi + (long)r * 1024 + z * 256 + c - 256); } };
struct LdDftD { const float* ct; const float* st;
    __device__ float4 load4(int, int k, int n, int) const { const int kk = k & 255; const bool s = k >= 256; float v[4];
#pragma unroll
        for (int j = 0; j < 4; ++j) { const int idx = ((kk * (n + j)) & 255) * 16; v[j] = (s ? st[idx] : ct[idx]) * (1.0f / 1024.0f); }
        return make_float4(v[0], v[1], v[2], v[3]); } };
struct LdGather { const float* p; long ld; const int* list; const int* off; const int* cnt;
    __device__ bool active(int z, int bm) const { return bm < cnt[z]; }
    __device__ float4 load4(int z, int r, int c) const { const bool ok = r < cnt[z]; const int t = list[off[z] + (ok ? r : 0)]; float4 v = *(const float4*)(p + (long)t * ld + c); const float m = ok ? 1.f : 0.f; v.x *= m; v.y *= m; v.z *= m; v.w *= m; return v; } };
struct LdRows { const float* p; long ld; const int* off; const int* cnt;
    __device__ bool active(int z, int bm) const { return bm < cnt[z]; }
    __device__ float4 load4(int z, int r, int c) const { const bool ok = r < cnt[z]; float4 v = *(const float4*)(p + (long)(off[z] + (ok ? r : 0)) * ld + c); const float m = ok ? 1.f : 0.f; v.x *= m; v.y *= m; v.z *= m; v.w *= m; return v; } };
struct LdGU { const float* wg; const float* wu;
    __device__ float4 load4(int z, int k, int n, int nl) const { const int bn = n - nl, wc = nl >> 6, t = (nl & 63) >> 4, c = nl & 15; const int f = (bn >> 1) + wc * 32 + (t & 1) * 16 + c;
        const long delta = (t < 2) ? 0l : (long)(wu - wg); return *(const float4*)(wg + delta + ((long)z * D + k) * FF + f); } };
struct EpGU { float* act; const int* off; const int* cnt; const float* pw;
    __device__ void operator()(int z, int bm, int bn, int wr, int wc, int lane, const f32x4 (&acc)[4][4]) const {
#pragma unroll
        for (int m = 0; m < 4; ++m)
#pragma unroll
            for (int t = 0; t < 2; ++t)
#pragma unroll
                for (int r = 0; r < 4; ++r) { const int row = bm + wr * 64 + m * 16 + (lane >> 4) * 4 + r; if (row >= cnt[z]) continue;
                    const int f = (bn >> 1) + wc * 32 + t * 16 + (lane & 15); const float g = acc[m][t][r], u = acc[m][t + 2][r];
                    const long pos = off[z] + row; act[pos * FF + f] = g / (1.f + __expf(-g)) * u * pw[pos]; }
    } };
struct EpDown { float* yd; const int* off; const int* cnt;
    __device__ void operator()(int z, int bm, int bn, int wr, int wc, int lane, const f32x4 (&acc)[4][4]) const {
#pragma unroll
        for (int m = 0; m < 4; ++m)
#pragma unroll
            for (int n = 0; n < 4; ++n)
#pragma unroll
                for (int r = 0; r < 4; ++r) { const int row = bm + wr * 64 + m * 16 + (lane >> 4) * 4 + r; if (row >= cnt[z]) continue;
                    yd[(long)(off[z] + row) * D + bn + wc * 64 + n * 16 + (lane & 15)] = acc[m][n][r]; }
    } };

struct Params {
    const float *x, *g_mix, *w_in, *w_pool, *pool_scale, *w_fourier, *w_out, *g_ffn, *wgr, *bgr, *wer, *ber, *w_gate, *w_up, *w_down, *g_final;
    float* out; char* ws;
};

__device__ __forceinline__ void transpose_item(const float* W, int K, int N, bf16_t* WT, LAS float* scr, int item, int lane) {
    const int nblk = N / 32, kb = item / nblk, nb = item % nblk, k0 = 64 * kb, n0 = 32 * nb;
#pragma unroll 8
    for (int i = 0; i < 32; ++i) { const int kk = 2 * i + (lane >> 5); scr[kk * 33 + (lane & 31)] = W[(size_t)(k0 + kk) * N + n0 + (lane & 31)]; }
    asm volatile("s_waitcnt lgkmcnt(0)" ::: "memory");
    const int c = lane & 7;
#pragma unroll
    for (int j = 0; j < 4; ++j) { const int n = (lane >> 3) + 8 * j; const LAS float* s = scr + (8 * c) * 33 + n;
        u32x4 o; o.x = pk2(s[0 * 33], s[1 * 33]); o.y = pk2(s[2 * 33], s[3 * 33]); o.z = pk2(s[4 * 33], s[5 * 33]); o.w = pk2(s[6 * 33], s[7 * 33]);
        *(u32x4*)(WT + (size_t)(n0 + n) * K + k0 + 8 * c) = o; }
    asm volatile("s_waitcnt lgkmcnt(0)" ::: "memory");
}

__device__ __forceinline__ void rms_row(const float* x, const float* g, float* outf, bf16_t* outb, int row, int lane, const float* yd, const int* tpos, f32x4 (&v)[8]) {
    const f32x4* xr = (const f32x4*)(x + (long)row * D) + lane; float s = 0.f;
#pragma unroll
    for (int j = 0; j < 8; ++j) v[j] = xr[64 * j];
    if (yd) {
        const int p0 = tpos[2 * row], p1 = tpos[2 * row + 1];
        const f32x4* y0 = (const f32x4*)(yd + (long)p0 * D) + lane; const f32x4* y1 = (const f32x4*)(yd + (long)p1 * D) + lane;
#pragma unroll
        for (int j = 0; j < 8; ++j) v[j] = v[j] + (y0[64 * j] + y1[64 * j]);
    }
#pragma unroll
    for (int j = 0; j < 8; ++j) s += (v[j].x * v[j].x + v[j].y * v[j].y) + (v[j].z * v[j].z + v[j].w * v[j].w);
    const float rstd = 1.0f / sqrtf(wave_sum(s) * (1.0f / D) + EPS);
    const f32x4* gr = (const f32x4*)g + lane;
#pragma unroll
    for (int j = 0; j < 8; ++j) v[j] = v[j] * rstd * gr[64 * j];
    if (outf) { f32x4* orow = (f32x4*)(outf + (long)row * D) + lane;
#pragma unroll
        for (int j = 0; j < 8; ++j) orow[64 * j] = v[j]; }
    if (outb) { u32x2* orow = (u32x2*)(outb + (long)row * D) + lane;
#pragma unroll
        for (int j = 0; j < 8; ++j) orow[64 * j] = (u32x2){pk2(v[j].x, v[j].y), pk2(v[j].z, v[j].w)}; }
}
__device__ __forceinline__ void router_row(const f32x4 (&v)[8], int row, int lane, const float* wgr, const float* bgr, const float* wer, const float* ber, int* tok_e, float* tok_w, int* cnt) {
    float acc[20];
#pragma unroll
    for (int j = 0; j < 20; ++j) acc[j] = 0.f;
#pragma unroll
    for (int j = 0; j < 8; ++j)
#pragma unroll
        for (int i = 0; i < 4; ++i) {
            const int d = 256 * j + 4 * lane + i; const float hv = v[j][i];
            const f32x4 wg = *(const f32x4*)(wgr + d * 4);
            acc[0] += hv * wg.x; acc[1] += hv * wg.y; acc[2] += hv * wg.z; acc[3] += hv * wg.w;
#pragma unroll
            for (int q = 0; q < 4; ++q) { const f32x4 we = *(const f32x4*)(wer + d * 16 + q * 4);
                acc[4 + q * 4 + 0] += hv * we.x; acc[4 + q * 4 + 1] += hv * we.y; acc[4 + q * 4 + 2] += hv * we.z; acc[4 + q * 4 + 3] += hv * we.w; }
        }
#pragma unroll
    for (int j = 0; j < 20; ++j) acc[j] = wave_sum(acc[j]);
    if (lane == 0) {
        float gl[4]; int gi = 0; float mx = -3.0e38f;
#pragma unroll
        for (int j = 0; j < 4; ++j) { gl[j] = acc[j] + bgr[j]; if (gl[j] > mx) { mx = gl[j]; gi = j; } }
        float se = 0.f;
#pragma unroll
        for (int j = 0; j < 4; ++j) se += __expf(gl[j] - mx);
        const float pg = 1.0f / se;
        float el[4];
#pragma unroll
        for (int j = 0; j < 4; ++j) { float t = 0.f;
#pragma unroll
            for (int q = 0; q < 4; ++q) t = (gi == q) ? acc[4 + q * 4 + j] + ber[q * 4 + j] : t;
            el[j] = t; }
        int i0 = 0; float v0 = el[0];
#pragma unroll
        for (int j = 1; j < 4; ++j) if (el[j] > v0) { v0 = el[j]; i0 = j; }
        int i1 = -1; float v1 = -3.0e38f;
#pragma unroll
        for (int j = 0; j < 4; ++j) if (j != i0 && el[j] > v1) { v1 = el[j]; i1 = j; }
        const float e1 = __expf(v1 - v0), inv = 1.0f / (1.0f + e1);
        const int ea = gi * 4 + i0, eb = gi * 4 + i1;
        tok_e[2 * row] = ea; tok_e[2 * row + 1] = eb; tok_w[2 * row] = pg * inv; tok_w[2 * row + 1] = pg * e1 * inv;
        atomicAdd(&cnt[ea], 1); atomicAdd(&cnt[eb], 1);
    }
}

__global__ __launch_bounds__(NTHR, 2) void mega(Params p) {
    extern __shared__ __attribute__((aligned(16))) unsigned char lds_raw[];
    LAS unsigned char* lds = (LAS unsigned char*)lds_raw;
    lds_tile_t As = (lds_tile_t)(lds); lds_tile_t Bs = (lds_tile_t)(lds + 256 * 40 * 2);
    cg::grid_group grid = cg::this_grid();
    const int tid = threadIdx.x, lane = tid & 63, wid = tid >> 6;
    const int gthreads = gridDim.x * NTHR, gtid = blockIdx.x * NTHR + tid;
    const int gwaves = gridDim.x * NWAVE, gwave = blockIdx.x * NWAVE + wid;
    char* ws = p.ws; float* out = p.out;
    bf16_t* HB = (bf16_t*)(ws + 0 * MiB);
    float* H2 = (float*)(ws + 0 * MiB);
    float* U = (float*)(ws + 128 * MiB);
    bf16_t* MIXB = (bf16_t*)(ws + 128 * MiB);
    float* YR = (float*)(ws + 256 * MiB); float* YI = (float*)(ws + 320 * MiB);
    float* P = (float*)(ws + 384 * MiB); float* FR = P;
    float* YD = (float*)(ws + 128 * MiB); float* ACT = (float*)(ws + 400 * MiB);
    bf16_t* WTIN = (bf16_t*)(ws + 464 * MiB);
    bf16_t* WTOUT = (bf16_t*)(ws + 472 * MiB);
    char* sm = ws + 480 * MiB;
    float* ct = (float*)(sm); float* st = (float*)(sm + 16384);
    int* cnt = (int*)(sm + 32768); int* off = cnt + 64; int* cur = cnt + 128;
    int* tok_e = (int*)(sm + 65536); float* tok_w = (float*)(sm + 65536 + 131072);
    int* list = (int*)(sm + 65536 + 2 * 131072); int* tpos = (int*)(sm + 65536 + 3 * 131072); float* pw = (float*)(sm + 65536 + 4 * 131072);
    f32x4 v[8];

    for (int i = gtid; i < 4096; i += gthreads) { ct[i] = cospif((float)i / 2048.0f); st[i] = sinpif((float)i / 2048.0f); }
    if (gtid < 192) cnt[gtid] = 0;
    { LAS float* scr = (LAS float*)(lds + wid * 16384);
      constexpr int I_W = (D / 64) * (D / 32);
      for (int it = gwave; it < 2 * I_W; it += gwaves) { if (it < I_W) transpose_item(p.w_in, D, D, WTIN, scr, it, lane); else transpose_item(p.w_out, D, D, WTOUT, scr, it - I_W, lane); } }
    for (int row = gwave; row < NTOK; row += gwaves) rms_row(p.x, p.g_mix, nullptr, HB, row, lane, nullptr, nullptr, v);
    grid.sync();
    { PolGemm1 S; S.init(NTOK / 256, D / 256, gridDim.x, blockIdx.x); S.K = D; S.A = HB; S.Bt = WTIN; S.C = U;
      pg8::gemm_phase(lds, S); }
    grid.sync();
    for (int idx = gtid; idx < NTOK * 256; idx += gthreads) {
        const int tok = idx >> 8, c4 = (idx & 255) * 4, g = c4 >> 8;
        const int b = tok / SEQ, t = tok % SEQ, k = 2 << g;
        int lo = t - (k - 1) / 2, hi = t + k / 2 + 1; lo = lo < 0 ? 0 : lo; hi = hi > SEQ ? SEQ : hi;
        f32x4 s = (f32x4){0.f, 0.f, 0.f, 0.f};
        for (int tt = lo; tt < hi; ++tt) s += *(const f32x4*)(U + ((long)(b * SEQ + tt)) * D + c4);
        const f32x4 self = *(const f32x4*)(U + (long)tok * D + c4);
        *(f32x4*)(P + (long)tok * PW + c4) = s * (1.0f / (float)(hi - lo)) - self;
    }
    { LdDftS a{ct, st}; LdB b{U + 1024, D, (long)SEQ * D, 0}; EpEl<StoreY> e{{YR, YI}};
      sgemm_phase(a, b, e, SEQ, FW / 128, 8192 / 256, BATCH, As, Bs); }
    grid.sync();
    { LdA a{P, PW, 0, GD}; LdB b{p.w_pool, GD, (long)GD * GD, 0}; EpEl<StoreB> e{{MIXB, D, 0, GD, p.pool_scale}};
      sgemm_phase(a, b, e, GD, GD / 128, NTOK / 256, 4, As, Bs); }
    grid.sync();
    { LdYri a{YR, YI}; LdDftD b{ct, st}; EpEl<StoreF> e{{FR, FW, 0, GD, nullptr}};
      sgemm_phase(a, b, e, 512, GD / 128, NTOK / 256, 4, As, Bs); }
    grid.sync();
    { LdA a{FR, FW, 0, GD}; LdB b{p.w_fourier, GD, (long)GD * GD, 0}; EpEl<StoreB> e{{MIXB + 1024, D, 0, GD, nullptr}};
      sgemm_phase(a, b, e, GD, GD / 128, NTOK / 256, 4, As, Bs); }
    grid.sync();
    { PolGemmOut S; S.init(NTOK / 256, D / 256, gridDim.x, blockIdx.x); S.K = D; S.A = MIXB; S.Bt = WTOUT; S.C = out; S.X = p.x;
      pg8::gemm_phase(lds, S); }
    grid.sync();
    for (int row = gwave; row < NTOK; row += gwaves) { rms_row(out, p.g_ffn, H2, nullptr, row, lane, nullptr, nullptr, v); router_row(v, row, lane, p.wgr, p.bgr, p.wer, p.ber, tok_e, tok_w, cnt); }
    grid.sync();
    { int offl[NE]; int s = 0;
#pragma unroll
      for (int e = 0; e < NE; ++e) { offl[e] = s; s += cnt[e]; }
      if (gtid < NE) { int o = 0; for (int e = 0; e < gtid; ++e) o += cnt[e]; off[gtid] = o; }
      for (int i = gtid; i < 2 * NTOK; i += gthreads) {
          const int e = tok_e[i]; int o = 0;
#pragma unroll
          for (int q = 0; q < NE; ++q) o = (q == e) ? offl[q] : o;
          const int pos = o + atomicAdd(&cur[e], 1);
          list[pos] = i >> 1; tpos[i] = pos; pw[pos] = tok_w[i]; } }
    grid.sync();
    { LdGather a{H2, D, list, off, cnt}; LdGU b{p.w_gate, p.w_up}; EpGU e{ACT, off, cnt, pw};
      sgemm_phase(a, b, e, D, 2 * FF / 128, NTOK / 256, NE, As, Bs); }
    grid.sync();
    { LdRows a{ACT, FF, off, cnt}; LdB b{p.w_down, D, (long)FF * D, 0}; EpDown e{YD, off, cnt};
      sgemm_phase(a, b, e, FF, D / 128, NTOK / 256, NE, As, Bs); }
    grid.sync();
    for (int row = gwave; row < NTOK; row += gwaves) rms_row(out, p.g_final, out, nullptr, row, lane, YD, tpos, v);
}

extern "C" void kernel_launch(void* const* d_in, const int* in_sizes, int n_in, void* d_out, int out_size, void* d_ws, size_t ws_size, hipStream_t stream) {
    static int grid_blocks = 0;
    if (!grid_blocks) {
        int dev = 0, cus = 0, per_cu = 0;
        (void)hipGetDevice(&dev);
        (void)hipDeviceGetAttribute(&cus, hipDeviceAttributeMultiprocessorCount, dev);
        (void)hipFuncSetAttribute((const void*)mega, hipFuncAttributeMaxDynamicSharedMemorySize, LDS_BYTES);
        (void)hipOccupancyMaxActiveBlocksPerMultiprocessor(&per_cu, mega, NTHR, LDS_BYTES);
        if (per_cu > 1) per_cu = 1;
        grid_blocks = cus * per_cu;
    }
    if (ws_size < 512 * MiB || grid_blocks <= 0) { fprintf(stderr, "workspace too small or no occupancy\n"); return; }
    Params p{};
    p.x = (const float*)d_in[0]; p.g_mix = (const float*)d_in[1]; p.w_in = (const float*)d_in[2]; p.w_pool = (const float*)d_in[3];
    p.pool_scale = (const float*)d_in[4]; p.w_fourier = (const float*)d_in[5]; p.w_out = (const float*)d_in[6]; p.g_ffn = (const float*)d_in[7];
    p.wgr = (const float*)d_in[8]; p.bgr = (const float*)d_in[9]; p.wer = (const float*)d_in[10]; p.ber = (const float*)d_in[11];
    p.w_gate = (const float*)d_in[12]; p.w_up = (const float*)d_in[13]; p.w_down = (const float*)d_in[14]; p.g_final = (const float*)d_in[15];
    p.out = (float*)d_out; p.ws = (char*)d_ws;
    void* args[] = {&p};
    hipError_t e = hipLaunchCooperativeKernel((void*)mega, dim3(grid_blocks), dim3(NTHR), args, LDS_BYTES, stream);
    if (e != hipSuccess) fprintf(stderr, "cooperative launch failed: %s (grid %d)\n", hipGetErrorString(e), grid_blocks);
}
```

```cpp
#include <hip/hip_runtime.h>
#include <stdint.h>
#include <stdio.h>
#include <hip/hip_cooperative_groups.h>
namespace cg = cooperative_groups;

typedef unsigned short bf16_t;
typedef short bf16x8 __attribute__((ext_vector_type(8)));
typedef float f32x4 __attribute__((ext_vector_type(4)));
typedef unsigned u32x4 __attribute__((ext_vector_type(4)));
typedef unsigned u32x2 __attribute__((ext_vector_type(2)));
#define LAS __attribute__((address_space(3)))

constexpr int D = 2048, BATCH = 4, SEQ = 4096, NTOK = BATCH * SEQ;
constexpr int PW = 1024, FW = 1024, GD = 256, NE = 16, FF = 512;
constexpr float EPS = 1e-6f;
constexpr int NTHR = 512, NWAVE = 8;
constexpr int LDS_BYTES = 147456;
constexpr size_t MiB = 1u << 20;

__device__ __forceinline__ unsigned f2bf(float f) { unsigned u = __float_as_uint(f); return (u + 0x7fffu + ((u >> 16) & 1u)) >> 16; }
__device__ __forceinline__ unsigned pk2(float lo, float hi) { return f2bf(lo) | (f2bf(hi) << 16); }
__device__ __forceinline__ float bf2f(unsigned short b) { return __uint_as_float(((unsigned)b) << 16); }
__device__ __forceinline__ float wave_sum(float v) {
#pragma unroll
    for (int o = 1; o < 64; o <<= 1) v += __shfl_xor(v, o);
    return v;
}

namespace pg8 {
constexpr int BM = 256, BK = 64, HALF = 128, HTB = HALF * BK * 2, STAGE_BYTES = 8 * HTB, NXCD = 8, WGM = 8;
__host__ __device__ __forceinline__ int lds_byte(int r, int c) { const int st = (r >> 4) * 2 + (c >> 5), rr = r & 15, cc = c & 31, ob = rr * 64 + cc * 2; return st * 1024 + (ob ^ (((ob >> 9) & 1) << 5)); }
__host__ __device__ __forceinline__ void stage_rc(int b, int& R, int& C) { const int st = b / 1024, sb = b % 1024, swz = sb ^ (((sb >> 9) & 1) << 5); R = (st >> 1) * 16 + swz / 64; C = (st & 1) * 32 + (swz % 64) / 2; }

struct Unit { int pm, pn, g, idx, rowbase, nrows; };

struct GridOrder {
    int nM, nN, nwg, G, c;
    __device__ void init(int nM_, int nN_, int G_, int c_) { nM = nM_; nN = nN_; nwg = nM * nN; G = G_; c = c_; }
    __device__ bool next(int i, Unit& u) const {
        const long L = (long)i * G + c; if (L >= nwg) return false;
        int wgid = (int)L; { const int q = nwg / NXCD, r = nwg % NXCD, xcd = wgid % NXCD, off = wgid / NXCD; wgid = (xcd < r ? xcd * (q + 1) : r * (q + 1) + (xcd - r) * q) + off; }
        const int nig = WGM * nN, gid = wgid / nig, fm = gid * WGM, gsz = (nM - fm) < WGM ? (nM - fm) : WGM;
        u.pm = fm + ((wgid % nig) % gsz); u.pn = (wgid % nig) / gsz; u.g = 0; u.idx = i; u.rowbase = 0; u.nrows = 256; return true;
    }
};

template <class P>
__device__ __forceinline__ void gemm_phase(LAS unsigned char* lds, const P& S) {
    int tid_ = threadIdx.x; asm volatile("" : "+v"(tid_));
    const int tid = tid_, wid = __builtin_amdgcn_readfirstlane(tid >> 6), lane = tid & 63, wr = wid >> 2, wc = wid & 3, fr = lane & 15, fq = lane >> 4;
    const int K = S.K, nt = K / BK;
    int Rp[2], Cp[2]; unsigned voffB[2];
#pragma unroll
    for (int i = 0; i < 2; ++i) { stage_rc(tid * 16 + i * 8192, Rp[i], Cp[i]); voffB[i] = (unsigned)(Rp[i] * K + Cp[i]) * 2u; }
    const size_t kstep = (size_t)(BK * 2);
    const size_t hstepB = (size_t)HALF * K * 2;
    const unsigned ldsw = (unsigned)wid * 1024u;
    const int aoff = lds_byte(wr * 64 + fr, fq * 8), boff = lds_byte(wc * 32 + fr, fq * 8);
#define PG8_SA(b, h) (((b) * 2 + (h)) * HTB)
#define PG8_SB(b, h) ((4 + (b) * 2 + (h)) * HTB)
#define PG8_STAGE(bufoff, gbase, voff) do { _Pragma("unroll") for (int _i = 0; _i < 2; ++_i) \
        __builtin_amdgcn_global_load_lds((const unsigned*)((const char*)(gbase) + (voff)[_i]), (LAS unsigned*)(lds + (bufoff) + ldsw + _i * 8192), 16, 0, 0); } while (0)
#define PG8_LDA(dst, b, h) do { _Pragma("unroll") for (int m = 0; m < 4; ++m) _Pragma("unroll") for (int k = 0; k < 2; ++k) dst[m][k] = *(const LAS bf16x8*)(lds + PG8_SA(b, h) + aoff + m * 2048 + k * 1024); } while (0)
#define PG8_LDB(dst, b, h) do { _Pragma("unroll") for (int n = 0; n < 2; ++n) _Pragma("unroll") for (int k = 0; k < 2; ++k) dst[n][k] = *(const LAS bf16x8*)(lds + PG8_SB(b, h) + boff + n * 2048 + k * 1024); } while (0)
#define PG8_MMA(ai, bj, At, Bt) do { __builtin_amdgcn_s_setprio(1); _Pragma("unroll") for (int m = 0; m < 4; ++m) _Pragma("unroll") for (int n = 0; n < 2; ++n) _Pragma("unroll") for (int k = 0; k < 2; ++k) \
        acc[ai][bj][m][n] = __builtin_amdgcn_mfma_f32_16x16x32_bf16(Bt[n][k], At[m][k], acc[ai][bj][m][n], 0, 0, 0); __builtin_amdgcn_s_setprio(0); } while (0)
#define PG8_WAIT_V(n) asm volatile("s_waitcnt vmcnt(" #n ")" ::: "memory")
#define PG8_WAIT_L(n) asm volatile("s_waitcnt lgkmcnt(" #n ")" ::: "memory")
#define PG8_BAR __builtin_amdgcn_s_barrier()
#define PG8_SCHED __builtin_amdgcn_sched_barrier(0)
    Unit cur, nxt; int ui = 0;
    if (!S.next(0, cur)) return;
    f32x4 acc[2][2][4][2];
#pragma unroll
    for (int a = 0; a < 2; ++a)
#pragma unroll
        for (int b = 0; b < 2; ++b)
#pragma unroll
            for (int m = 0; m < 4; ++m)
#pragma unroll
                for (int n = 0; n < 2; ++n) acc[a][b][m][n] = (f32x4){0.f, 0.f, 0.f, 0.f};
    bf16x8 At[4][2], B0[2][2], B1[2][2];
    const char* const aB = S.a_base();
    unsigned oc0[2], oc1[2];
#pragma unroll
    for (int i = 0; i < 2; ++i) { oc0[i] = S.a_row_off(cur, Rp[i]) + (unsigned)Cp[i] * 2u; oc1[i] = S.a_row_off(cur, HALF + Rp[i]) + (unsigned)Cp[i] * 2u; }
    const char* cB = S.b_tile(cur);
    PG8_STAGE(PG8_SB(0, 0), cB, voffB); PG8_STAGE(PG8_SB(0, 1), cB + hstepB, voffB); PG8_STAGE(PG8_SA(0, 0), aB, oc0); PG8_STAGE(PG8_SA(0, 1), aB, oc1);
    if (wr == 1) PG8_BAR;
    PG8_WAIT_V(2); PG8_BAR;
    PG8_STAGE(PG8_SB(1, 0), cB + kstep, voffB); PG8_STAGE(PG8_SA(1, 0), aB + kstep, oc0); PG8_STAGE(PG8_SB(1, 1), cB + hstepB + kstep, voffB);
    PG8_WAIT_V(6); PG8_BAR;
    for (;;) {
        const bool has_next = S.next(ui + 1, nxt);
        unsigned on0[2], on1[2];
#pragma unroll
        for (int i = 0; i < 2; ++i) { on0[i] = has_next ? S.a_row_off(nxt, Rp[i]) + (unsigned)Cp[i] * 2u : oc0[i]; on1[i] = has_next ? S.a_row_off(nxt, HALF + Rp[i]) + (unsigned)Cp[i] * 2u : oc1[i]; }
        const char* nB = has_next ? S.b_tile(nxt) : cB;
        for (int t = 0; t < nt; t += 2) {
            const bool last = (t == nt - 2);
            const char* a1 = aB + (size_t)(t + 1) * kstep;
            const char* a2 = last ? aB : aB + (size_t)(t + 2) * kstep; const char* b2 = last ? nB : cB + (size_t)(t + 2) * kstep;
            const char* a3 = a2 + kstep; const char* b3 = b2 + kstep;
            unsigned o20[2], o21[2];
#pragma unroll
            for (int i = 0; i < 2; ++i) { o20[i] = last ? on0[i] : oc0[i]; o21[i] = last ? on1[i] : oc1[i]; }
            PG8_LDB(B0, 0, 0); PG8_LDB(B1, 0, 1); PG8_SCHED; PG8_LDA(At, 0, 0); PG8_STAGE(PG8_SA(1, 1), a1, oc1);
            PG8_WAIT_V(8); PG8_WAIT_L(0); PG8_BAR; PG8_MMA(0, 0, At, B0); PG8_MMA(0, 1, At, B1); PG8_BAR; PG8_SCHED;
            PG8_LDA(At, 0, 1); PG8_STAGE(PG8_SB(0, 0), b2, voffB); PG8_STAGE(PG8_SB(0, 1), b2 + hstepB, voffB); PG8_STAGE(PG8_SA(0, 0), a2, o20);
            PG8_WAIT_V(8); PG8_WAIT_L(0); PG8_BAR; PG8_MMA(1, 0, At, B0); PG8_MMA(1, 1, At, B1); PG8_BAR; PG8_SCHED;
            PG8_LDB(B0, 1, 0); PG8_LDB(B1, 1, 1); PG8_SCHED; PG8_LDA(At, 1, 0); PG8_STAGE(PG8_SA(0, 1), a2, o21);
            PG8_WAIT_V(8); PG8_WAIT_L(0); PG8_BAR; PG8_MMA(0, 0, At, B0); PG8_MMA(0, 1, At, B1); PG8_BAR; PG8_SCHED;
            PG8_LDA(At, 1, 1); PG8_STAGE(PG8_SB(1, 0), b3, voffB); PG8_STAGE(PG8_SB(1, 1), b3 + hstepB, voffB); PG8_STAGE(PG8_SA(1, 0), a3, o20);
            PG8_WAIT_V(8); PG8_WAIT_L(0); PG8_BAR; PG8_MMA(1, 0, At, B0); PG8_MMA(1, 1, At, B1); PG8_BAR; PG8_SCHED;
        }
        if (wr == 0) PG8_BAR;
        S.epi(acc, cur, wr, wc, fr, fq);
        if (!has_next) break;
#pragma unroll
        for (int a = 0; a < 2; ++a)
#pragma unroll
            for (int b = 0; b < 2; ++b)
#pragma unroll
                for (int m = 0; m < 4; ++m)
#pragma unroll
                    for (int n = 0; n < 2; ++n) acc[a][b][m][n] = (f32x4){0.f, 0.f, 0.f, 0.f};
        cur = nxt; cB = nB; ++ui;
#pragma unroll
        for (int i = 0; i < 2; ++i) { oc0[i] = on0[i]; oc1[i] = on1[i]; }
        if (wr == 1) PG8_BAR;
    }
    PG8_WAIT_V(0);
    PG8_BAR;
#undef PG8_SA
#undef PG8_SB
#undef PG8_STAGE
#undef PG8_LDA
#undef PG8_LDB
#undef PG8_MMA
#undef PG8_WAIT_V
#undef PG8_WAIT_L
#undef PG8_BAR
#undef PG8_SCHED
}
}

struct PolBf16 : pg8::GridOrder {
    int K; const bf16_t* A; const bf16_t* Bt; bf16_t* C; int lda_b, acol_b, ldc, ccol0;
    __device__ const char* a_base() const { return (const char*)A; }
    __device__ unsigned a_row_off(const pg8::Unit& u, int r) const { return (unsigned)(u.pm * 256 + r) * (unsigned)lda_b + (unsigned)(u.pn * acol_b); }
    __device__ const char* b_tile(const pg8::Unit& u) const { return (const char*)Bt + (size_t)u.pn * 256 * K * 2; }
    __device__ void epi(const f32x4 (&acc)[2][2][4][2], const pg8::Unit& u, int wr, int wc, int fr, int fq) const {
        const int row0 = u.pm * 256 + wr * 64 + fr, col0 = ccol0 + u.pn * 256 + wc * 32 + 4 * fq;
#pragma unroll
        for (int ai = 0; ai < 2; ++ai)
#pragma unroll
            for (int m = 0; m < 4; ++m) { bf16_t* rowp = C + (size_t)(row0 + ai * 128 + m * 16) * ldc + col0;
#pragma unroll
                for (int bj = 0; bj < 2; ++bj)
#pragma unroll
                    for (int n = 0; n < 2; ++n) { const f32x4 a = acc[ai][bj][m][n]; *(u32x2*)(rowp + bj * 128 + n * 16) = (u32x2){pk2(a[0], a[1]), pk2(a[2], a[3])}; } }
    }
};
struct PolGemmOut : pg8::GridOrder {
    int K; const bf16_t* A; const bf16_t* Bt; float* C; const float* X;
    __device__ const char* a_base() const { return (const char*)A; }
    __device__ unsigned a_row_off(const pg8::Unit& u, int r) const { return (unsigned)(u.pm * 256 + r) * (unsigned)(K * 2); }
    __device__ const char* b_tile(const pg8::Unit& u) const { return (const char*)Bt + (size_t)u.pn * 256 * K * 2; }
    __device__ void epi(const f32x4 (&acc)[2][2][4][2], const pg8::Unit& u, int wr, int wc, int fr, int fq) const {
        const int row0 = u.pm * 256 + wr * 64 + fr, col0 = u.pn * 256 + wc * 32 + 4 * fq;
#pragma unroll
        for (int ai = 0; ai < 2; ++ai)
#pragma unroll
            for (int m = 0; m < 4; ++m) { const size_t o = (size_t)(row0 + ai * 128 + m * 16) * D + col0;
#pragma unroll
                for (int bj = 0; bj < 2; ++bj)
#pragma unroll
                    for (int n = 0; n < 2; ++n) *(f32x4*)(C + o + bj * 128 + n * 16) = acc[ai][bj][m][n] + *(const f32x4*)(X + o + bj * 128 + n * 16); }
    }
};


struct MoeOrder {
    int nN, rtx, xcd, slot, G; const int* cnt;
    __device__ void init(int nN_, int G_, int c_, const int* cnt_) { nN = nN_; G = G_; xcd = c_ & 7; slot = c_ >> 3; rtx = (G_ >> 3) / nN_; cnt = cnt_; }
    __device__ bool next(int i, pg8::Unit& u) const {
        const int rt = (i * 8 + xcd) * rtx + slot % rtx; u.pn = slot / rtx; u.idx = i;
        int acc_t = 0, acc_r = 0; bool found = false; u.pm = 0; u.g = 0; u.rowbase = 0; u.nrows = 0;
        for (int e = 0; e < NE; ++e) { const int c = cnt[e], nt_e = (c + 255) >> 8;
            if (!found && rt < acc_t + nt_e) { found = true; u.g = e; u.pm = rt - acc_t; u.rowbase = acc_r + u.pm * 256; const int rem = c - u.pm * 256; u.nrows = rem < 256 ? rem : 256; }
            acc_t += nt_e; acc_r += c; }
        return found;
    }
};
__device__ __forceinline__ float silu_f(float g) { return g / (1.f + __expf(-g)); }
struct PolMoeUp : MoeOrder {
    int K; const bf16_t* A; const bf16_t* Bt; bf16_t* ACT; const float* pw; const LAS unsigned* rowtab;
    __device__ const char* a_base() const { return (const char*)A; }
    __device__ unsigned a_row_off(const pg8::Unit& u, int r) const { return rowtab[u.idx * 256 + r]; }
    __device__ const char* b_tile(const pg8::Unit& u) const { return (const char*)Bt + ((size_t)u.g * 1024 + (size_t)u.pn * 256) * K * 2; }
    __device__ void epi(const f32x4 (&acc)[2][2][4][2], const pg8::Unit& u, int wr, int wc, int fr, int fq) const {
#pragma unroll
        for (int ai = 0; ai < 2; ++ai)
#pragma unroll
            for (int m = 0; m < 4; ++m) { const int r = ai * 128 + wr * 64 + m * 16 + fr; if (r >= u.nrows) continue;
                const size_t pos = (size_t)u.rowbase + r; const float w = pw[pos];
#pragma unroll
                for (int n = 0; n < 2; ++n) { const f32x4 g = acc[ai][0][m][n], v = acc[ai][1][m][n];
                    const int f = u.pn * 128 + wc * 32 + n * 16 + fq * 4;
                    *(u32x2*)(ACT + pos * FF + f) = (u32x2){pk2(silu_f(g[0]) * v[0] * w, silu_f(g[1]) * v[1] * w), pk2(silu_f(g[2]) * v[2] * w, silu_f(g[3]) * v[3] * w)}; } }
    }
};
struct PolMoeDown : MoeOrder {
    int K; const bf16_t* A; const bf16_t* Bt; bf16_t* YD;
    __device__ const char* a_base() const { return (const char*)A; }
    __device__ unsigned a_row_off(const pg8::Unit& u, int r) const { const int rr = r < u.nrows ? r : u.nrows - 1; return (unsigned)(u.rowbase + rr) * (unsigned)(K * 2); }
    __device__ const char* b_tile(const pg8::Unit& u) const { return (const char*)Bt + ((size_t)u.g * 2048 + (size_t)u.pn * 256) * K * 2; }
    __device__ void epi(const f32x4 (&acc)[2][2][4][2], const pg8::Unit& u, int wr, int wc, int fr, int fq) const {
#pragma unroll
        for (int ai = 0; ai < 2; ++ai)
#pragma unroll
            for (int m = 0; m < 4; ++m) { const int r = ai * 128 + wr * 64 + m * 16 + fr; if (r >= u.nrows) continue;
                bf16_t* rowp = YD + ((size_t)u.rowbase + r) * D + u.pn * 256 + wc * 32 + fq * 4;
#pragma unroll
                for (int bj = 0; bj < 2; ++bj)
#pragma unroll
                    for (int n = 0; n < 2; ++n) { const f32x4 a = acc[ai][bj][m][n]; *(u32x2*)(rowp + bj * 128 + n * 16) = (u32x2){pk2(a[0], a[1]), pk2(a[2], a[3])}; } }
    }
};

typedef bf16_t LAS (*lds_tile_t)[40];
template <class AL, class BL, class EP>
__device__ __forceinline__ void gemm_tile(const AL& al, const BL& bl, const EP& ep, const int K, const int bxi, const int byi, const int bz, lds_tile_t As, lds_tile_t Bs) {
    const int tid = threadIdx.x, wid = tid >> 6, lane = tid & 63;
    const int bm = byi * 256, bn = bxi * 128;
    const int wr = wid >> 1, wc = wid & 1;
    f32x4 acc[4][4];
#pragma unroll
    for (int m = 0; m < 4; ++m)
#pragma unroll
        for (int n = 0; n < 4; ++n) acc[m][n] = (f32x4){0.f, 0.f, 0.f, 0.f};
    for (int k0 = 0; k0 < K; k0 += 32) {
#pragma unroll
        for (int i = 0; i < 4; ++i) {
            const int row = (tid >> 3) + 64 * i, kk = (tid & 7) * 4;
            const float4 v = al.load4(bz, bm + row, k0 + kk);
            *(LAS u32x2*)&As[row][kk] = (u32x2){pk2(v.x, v.y), pk2(v.z, v.w)};
        }
#pragma unroll
        for (int i = 0; i < 2; ++i) {
            const int k = (tid >> 5) + 16 * i, n = (tid & 31) * 4;
            const float4 v = bl.load4(bz, k0 + k, bn + n, n);
            Bs[n + 0][k] = (bf16_t)f2bf(v.x); Bs[n + 1][k] = (bf16_t)f2bf(v.y); Bs[n + 2][k] = (bf16_t)f2bf(v.z); Bs[n + 3][k] = (bf16_t)f2bf(v.w);
        }
        __syncthreads();
        bf16x8 a[4], b[4];
#pragma unroll
        for (int m = 0; m < 4; ++m) a[m] = *(const LAS bf16x8*)&As[wr * 64 + m * 16 + (lane & 15)][(lane >> 4) * 8];
#pragma unroll
        for (int n = 0; n < 4; ++n) b[n] = *(const LAS bf16x8*)&Bs[wc * 64 + n * 16 + (lane & 15)][(lane >> 4) * 8];
#pragma unroll
        for (int m = 0; m < 4; ++m)
#pragma unroll
            for (int n = 0; n < 4; ++n) acc[m][n] = __builtin_amdgcn_mfma_f32_16x16x32_bf16(a[m], b[n], acc[m][n], 0, 0, 0);
        __syncthreads();
    }
    ep(bz, bm, bn, wr, wc, lane, acc);
}
template <class AL, class BL, class EP>
__device__ __forceinline__ void sgemm_phase(const AL& al, const BL& bl, const EP& ep, int K, int nx, int ny, int nz, lds_tile_t As, lds_tile_t Bs) {
    const int total = nx * ny * nz;
    for (int t = blockIdx.x; t < total; t += gridDim.x) {
        const int bxi = t % nx, byi = (t / nx) % ny, bz = t / (nx * ny);
        if (!al.active(bz, byi * 256)) continue;
        gemm_tile(al, bl, ep, K, bxi, byi, bz, As, Bs);
    }
}

struct LdA { const float* p; long ld, zs; long coff_z;
    __device__ bool active(int, int) const { return true; }
    __device__ float4 load4(int z, int r, int c) const { return *(const float4*)(p + (long)z * zs + (long)r * ld + (long)z * coff_z + c); } };
struct LdB { const float* p; long ld, zs; long coff_z;
    __device__ float4 load4(int z, int k, int n, int) const { return *(const float4*)(p + (long)z * zs + (long)k * ld + (long)z * coff_z + n); } };
template <class F> struct EpEl { F f;
    __device__ void operator()(int z, int bm, int bn, int wr, int wc, int lane, const f32x4 (&acc)[4][4]) const {
#pragma unroll
        for (int m = 0; m < 4; ++m)
#pragma unroll
            for (int n = 0; n < 4; ++n)
#pragma unroll
                for (int r = 0; r < 4; ++r) f(z, bm + wr * 64 + m * 16 + (lane >> 4) * 4 + r, bn + wc * 64 + n * 16 + (lane & 15), acc[m][n][r]);
    } };
struct StoreF { float* p; long ld, zs; long coff_z; const float* scale;
    __device__ void operator()(int z, int r, int n, float v) const {
        const long o = (long)z * zs + (long)r * ld + (long)z * coff_z + n;
        if (scale) v *= scale[z * coff_z + n];
        p[o] = v; } };
struct StoreB { bf16_t* p; long ld, zs; long coff_z; const float* scale;
    __device__ void operator()(int z, int r, int n, float v) const {
        const long o = (long)z * zs + (long)r * ld + (long)z * coff_z + n;
        if (scale) v *= scale[z * coff_z + n];
        p[o] = (bf16_t)f2bf(v); } };
struct LdDftS { const float* ct; const float* st;
    __device__ bool active(int, int) const { return true; }
    __device__ float4 load4(int, int m, int s) const { const int k = m & 4095; const bool im = m >= 4096; float v[4];
#pragma unroll
        for (int j = 0; j < 4; ++j) { const int idx = (k * (s + j)) & 4095; v[j] = im ? -st[idx] : ct[idx]; }
        return make_float4(v[0], v[1], v[2], v[3]); } };
struct StoreY { float* yr; float* yi;
    __device__ void operator()(int z, int m, int n, float v) const { if (m < 4096) yr[((long)z * 4096 + m) * 1024 + n] = v; else yi[((long)z * 4096 + (m - 4096)) * 1024 + n] = v; } };
struct LdYri { const float* yr; const float* yi;
    __device__ bool active(int, int) const { return true; }
    __device__ float4 load4(int z, int r, int c) const { return c < 256 ? *(const float4*)(yr + (long)r * 1024 + z * 256 + c) : *(const float4*)(yi + (long)r * 1024 + z * 256 + c - 256); } };
struct LdDftD { const float* ct; const float* st;
    __device__ float4 load4(int, int k, int n, int) const { const int kk = k & 255; const bool s = k >= 256; float v[4];
#pragma unroll
        for (int j = 0; j < 4; ++j) { const int idx = ((kk * (n + j)) & 255) * 16; v[j] = (s ? st[idx] : ct[idx]) * (1.0f / 1024.0f); }
        return make_float4(v[0], v[1], v[2], v[3]); } };
struct LdGather { const float* p; long ld; const int* list; const int* off; const int* cnt;
    __device__ bool active(int z, int bm) const { return bm < cnt[z]; }
    __device__ float4 load4(int z, int r, int c) const { const bool ok = r < cnt[z]; const int t = list[off[z] + (ok ? r : 0)]; float4 v = *(const float4*)(p + (long)t * ld + c); const float m = ok ? 1.f : 0.f; v.x *= m; v.y *= m; v.z *= m; v.w *= m; return v; } };
struct LdRows { const float* p; long ld; const int* off; const int* cnt;
    __device__ bool active(int z, int bm) const { return bm < cnt[z]; }
    __device__ float4 load4(int z, int r, int c) const { const bool ok = r < cnt[z]; float4 v = *(const float4*)(p + (long)(off[z] + (ok ? r : 0)) * ld + c); const float m = ok ? 1.f : 0.f; v.x *= m; v.y *= m; v.z *= m; v.w *= m; return v; } };
struct LdGU { const float* wg; const float* wu;
    __device__ float4 load4(int z, int k, int n, int nl) const { const int bn = n - nl, wc = nl >> 6, t = (nl & 63) >> 4, c = nl & 15; const int f = (bn >> 1) + wc * 32 + (t & 1) * 16 + c;
        const long delta = (t < 2) ? 0l : (long)(wu - wg); return *(const float4*)(wg + delta + ((long)z * D + k) * FF + f); } };
struct EpGU { float* act; const int* off; const int* cnt; const float* pw;
    __device__ void operator()(int z, int bm, int bn, int wr, int wc, int lane, const f32x4 (&acc)[4][4]) const {
#pragma unroll
        for (int m = 0; m < 4; ++m)
#pragma unroll
            for (int t = 0; t < 2; ++t)
#pragma unroll
                for (int r = 0; r < 4; ++r) { const int row = bm + wr * 64 + m * 16 + (lane >> 4) * 4 + r; if (row >= cnt[z]) continue;
                    const int f = (bn >> 1) + wc * 32 + t * 16 + (lane & 15); const float g = acc[m][t][r], u = acc[m][t + 2][r];
                    const long pos = off[z] + row; act[pos * FF + f] = g / (1.f + __expf(-g)) * u * pw[pos]; }
    } };
struct EpDown { float* yd; const int* off; const int* cnt;
    __device__ void operator()(int z, int bm, int bn, int wr, int wc, int lane, const f32x4 (&acc)[4][4]) const {
#pragma unroll
        for (int m = 0; m < 4; ++m)
#pragma unroll
            for (int n = 0; n < 4; ++n)
#pragma unroll
                for (int r = 0; r < 4; ++r) { const int row = bm + wr * 64 + m * 16 + (lane >> 4) * 4 + r; if (row >= cnt[z]) continue;
                    yd[(long)(off[z] + row) * D + bn + wc * 64 + n * 16 + (lane & 15)] = acc[m][n][r]; }
    } };

struct Params {
    const float *x, *g_mix, *w_in, *w_pool, *pool_scale, *w_fourier, *w_out, *g_ffn, *wgr, *bgr, *wer, *ber, *w_gate, *w_up, *w_down, *g_final;
    float* out; char* ws;
};

__device__ __forceinline__ void transpose_item(const float* W, int ldw, int k0, int n0, bf16_t* dst, int dstK, LAS float* scr, int lane) {
#pragma unroll 8
    for (int i = 0; i < 32; ++i) { const int kk = 2 * i + (lane >> 5); scr[kk * 33 + (lane & 31)] = W[(size_t)(k0 + kk) * ldw + n0 + (lane & 31)]; }
    asm volatile("s_waitcnt lgkmcnt(0)" ::: "memory");
    const int c = lane & 7;
#pragma unroll
    for (int j = 0; j < 4; ++j) { const int n = (lane >> 3) + 8 * j; const LAS float* sp = scr + (8 * c) * 33 + n;
        u32x4 o; o.x = pk2(sp[0 * 33], sp[1 * 33]); o.y = pk2(sp[2 * 33], sp[3 * 33]); o.z = pk2(sp[4 * 33], sp[5 * 33]); o.w = pk2(sp[6 * 33], sp[7 * 33]);
        *(u32x4*)(dst + (size_t)n * dstK + k0 + 8 * c) = o; }
    asm volatile("s_waitcnt lgkmcnt(0)" ::: "memory");
}

__device__ __forceinline__ void rms_row(const float* x, const float* g, float* outf, bf16_t* outb, int row, int lane, const bf16_t* yd, const int* tpos, f32x4 (&v)[8]) {
    const f32x4* xr = (const f32x4*)(x + (long)row * D) + lane; float s = 0.f;
#pragma unroll
    for (int j = 0; j < 8; ++j) v[j] = xr[64 * j];
    if (yd) {
        const int p0 = tpos[2 * row], p1 = tpos[2 * row + 1];
        const u32x2* y0 = (const u32x2*)(yd + (long)p0 * D) + lane; const u32x2* y1 = (const u32x2*)(yd + (long)p1 * D) + lane;
#pragma unroll
        for (int j = 0; j < 8; ++j) { const u32x2 a = y0[64 * j], b = y1[64 * j];
            v[j].x += __uint_as_float(a.x << 16) + __uint_as_float(b.x << 16); v[j].y += __uint_as_float(a.x & 0xffff0000u) + __uint_as_float(b.x & 0xffff0000u);
            v[j].z += __uint_as_float(a.y << 16) + __uint_as_float(b.y << 16); v[j].w += __uint_as_float(a.y & 0xffff0000u) + __uint_as_float(b.y & 0xffff0000u); }
    }
#pragma unroll
    for (int j = 0; j < 8; ++j) s += (v[j].x * v[j].x + v[j].y * v[j].y) + (v[j].z * v[j].z + v[j].w * v[j].w);
    const float rstd = 1.0f / sqrtf(wave_sum(s) * (1.0f / D) + EPS);
    const f32x4* gr = (const f32x4*)g + lane;
#pragma unroll
    for (int j = 0; j < 8; ++j) v[j] = v[j] * rstd * gr[64 * j];
    if (outf) { f32x4* orow = (f32x4*)(outf + (long)row * D) + lane;
#pragma unroll
        for (int j = 0; j < 8; ++j) orow[64 * j] = v[j]; }
    if (outb) { u32x2* orow = (u32x2*)(outb + (long)row * D) + lane;
#pragma unroll
        for (int j = 0; j < 8; ++j) orow[64 * j] = (u32x2){pk2(v[j].x, v[j].y), pk2(v[j].z, v[j].w)}; }
}
__device__ __forceinline__ void router_row(const f32x4 (&v)[8], int row, int lane, const float* wgr, const float* bgr, const float* wer, const float* ber, int* tok_e, float* tok_w, int* cnt) {
    float acc[20];
#pragma unroll
    for (int j = 0; j < 20; ++j) acc[j] = 0.f;
#pragma unroll
    for (int j = 0; j < 8; ++j)
#pragma unroll
        for (int i = 0; i < 4; ++i) {
            const int d = 256 * j + 4 * lane + i; const float hv = v[j][i];
            const f32x4 wg = *(const f32x4*)(wgr + d * 4);
            acc[0] += hv * wg.x; acc[1] += hv * wg.y; acc[2] += hv * wg.z; acc[3] += hv * wg.w;
#pragma unroll
            for (int q = 0; q < 4; ++q) { const f32x4 we = *(const f32x4*)(wer + d * 16 + q * 4);
                acc[4 + q * 4 + 0] += hv * we.x; acc[4 + q * 4 + 1] += hv * we.y; acc[4 + q * 4 + 2] += hv * we.z; acc[4 + q * 4 + 3] += hv * we.w; }
        }
#pragma unroll
    for (int j = 0; j < 20; ++j) acc[j] = wave_sum(acc[j]);
    if (lane == 0) {
        float gl[4]; int gi = 0; float mx = -3.0e38f;
#pragma unroll
        for (int j = 0; j < 4; ++j) { gl[j] = acc[j] + bgr[j]; if (gl[j] > mx) { mx = gl[j]; gi = j; } }
        float se = 0.f;
#pragma unroll
        for (int j = 0; j < 4; ++j) se += __expf(gl[j] - mx);
        const float pg = 1.0f / se;
        float el[4];
#pragma unroll
        for (int j = 0; j < 4; ++j) { float t = 0.f;
#pragma unroll
            for (int q = 0; q < 4; ++q) t = (gi == q) ? acc[4 + q * 4 + j] + ber[q * 4 + j] : t;
            el[j] = t; }
        int i0 = 0; float v0 = el[0];
#pragma unroll
        for (int j = 1; j < 4; ++j) if (el[j] > v0) { v0 = el[j]; i0 = j; }
        int i1 = -1; float v1 = -3.0e38f;
#pragma unroll
        for (int j = 0; j < 4; ++j) if (j != i0 && el[j] > v1) { v1 = el[j]; i1 = j; }
        const float e1 = __expf(v1 - v0), inv = 1.0f / (1.0f + e1);
        const int ea = gi * 4 + i0, eb = gi * 4 + i1;
        tok_e[2 * row] = ea; tok_e[2 * row + 1] = eb; tok_w[2 * row] = pg * inv; tok_w[2 * row + 1] = pg * e1 * inv;
        atomicAdd(&cnt[ea], 1); atomicAdd(&cnt[eb], 1);
    }
}


typedef short s16x4 __attribute__((ext_vector_type(4)));
constexpr int DP = 544, DFT_TILE = 64 * DP, DFT_TAB_OFF = 2 * DFT_TILE;
__device__ __forceinline__ s16x4 tr16(const LAS unsigned char* p) { return __builtin_bit_cast(s16x4, __builtin_amdgcn_ds_read_tr16_b64_v4i16((LAS s16x4*)p)); }
__device__ __forceinline__ int dft_row_of_slot(int ks, int fq, int jj) { return 32 * ks + 16 * (jj >> 2) + 4 * fq + (jj & 3); }
__device__ __forceinline__ void dft_make_tables(bf16_t* t1, bf16_t* t2, int gtid, int gthreads) {
    for (int i = gtid; i < 2 * 8 * 64 * 8; i += gthreads) { const int jj = i & 7, l = (i >> 3) & 63, nt = (i >> 9) & 7, ks = i >> 12; const int fr = l & 15, fq = l >> 4;
        const int c = 16 * (nt & 3) + fr, a = dft_row_of_slot(ks, fq, jj); const float x = (float)((a * c) & 63) / 32.0f;
        t1[i] = (bf16_t)f2bf(nt < 4 ? cospif(x) : -sinpif(x)); }
    for (int i = gtid; i < 4 * 8 * 64 * 8; i += gthreads) { const int jj = i & 7, l = (i >> 3) & 63, nt = (i >> 9) & 7, ks = i >> 12; const int fr = l & 15, fq = l >> 4;
        const int d = 16 * (nt & 3) + fr, bp = dft_row_of_slot(ks & 1, fq, jj), part = ks >> 1; const float x = (float)((bp * d) & 63) / 32.0f;
        float v; if (nt < 4) v = part == 0 ? cospif(x) : sinpif(x); else v = part == 0 ? -sinpif(x) : cospif(x);
        t2[i] = (bf16_t)f2bf(v); }
}
template <int STAGE>
__device__ __forceinline__ void dft_pass(LAS unsigned char* lds, const bf16_t* src, bf16_t* dst, const bf16_t* tab, const float* ct, const float* st) {
    constexpr int NL = STAGE == 1 ? 4 : 8, NKS = STAGE == 1 ? 2 : 4;
    int tid_ = threadIdx.x; asm volatile("" : "+v"(tid_));
    const int tid = tid_, lane = tid & 63, w = __builtin_amdgcn_readfirstlane(tid >> 6), fr = lane & 15, fq = lane >> 4;
    const int G = gridDim.x, bx = blockIdx.x, vcu = (G % 8 == 0) ? (bx % 8) * (G / 8) + bx / 8 : bx;
    for (int i = tid; i < NKS * 8 * 64; i += NTHR) *(LAS u32x4*)(lds + DFT_TAB_OFF + i * 16) = *(const u32x4*)(tab + (size_t)i * 8);
    u32x4 pre[NL];
    auto unit_src = [&](int uid, int i) -> const bf16_t* {
        const int h = uid & 3, x = (uid >> 2) & 63, b = uid >> 8, idx = tid + NTHR * i, row = (idx >> 5) & 63, ch = idx & 31;
        if (STAGE == 1) return src + ((size_t)(b * SEQ + 64 * row + x)) * D + 1024 + 256 * h + ch * 8;
        const int part = idx >> 11; return src + ((((size_t)(b * 64 + x) * 2 + part) * 64 + row) * 1024) + 256 * h + ch * 8; };
    int uid = vcu;
    if (uid < 1024) {
#pragma unroll
        for (int i = 0; i < NL; ++i) pre[i] = *(const u32x4*)unit_src(uid, i); }
    for (; uid < 1024; uid += G) {
#pragma unroll
        for (int i = 0; i < NL; ++i) { const int idx = tid + NTHR * i, part = idx >> 11, row = (idx >> 5) & 63, ch = idx & 31; *(LAS u32x4*)(lds + part * DFT_TILE + row * DP + ch * 16) = pre[i]; }
        __syncthreads();
        if (uid + G < 1024) {
#pragma unroll
            for (int i = 0; i < NL; ++i) pre[i] = *(const u32x4*)unit_src(uid + G, i); }
        const int h = uid & 3, x = (uid >> 2) & 63, b = uid >> 8;
        f32x4 acc[2][8];
#pragma unroll
        for (int mt = 0; mt < 2; ++mt)
#pragma unroll
            for (int nt = 0; nt < 8; ++nt) acc[mt][nt] = (f32x4){0.f, 0.f, 0.f, 0.f};
#pragma unroll
        for (int ks = 0; ks < NKS; ++ks) {
            bf16x8 A[2];
#pragma unroll
            for (int mt = 0; mt < 2; ++mt) {
                const LAS unsigned char* base = lds + (ks >> 1) * DFT_TILE + (32 * (ks & 1) + 4 * fq + (fr >> 2)) * DP + (32 * w + 8 * (fr & 3) + 4 * mt) * 2;
                const s16x4 lo = tr16(base), hi = tr16(base + 16 * DP);
                A[mt] = (bf16x8){lo[0], lo[1], lo[2], lo[3], hi[0], hi[1], hi[2], hi[3]}; }
#pragma unroll
            for (int nt = 0; nt < 8; ++nt) { const bf16x8 B = *(const LAS bf16x8*)(lds + DFT_TAB_OFF + ((ks * 8 + nt) * 64 + lane) * 16);
#pragma unroll
                for (int mt = 0; mt < 2; ++mt) acc[mt][nt] = __builtin_amdgcn_mfma_f32_16x16x32_bf16(A[mt], B, acc[mt][nt], 0, 0, 0); }
        }
        const int colb = 256 * h + 32 * w + 8 * fq;
#pragma unroll
        for (int nt = 0; nt < 4; ++nt) {
            const int f = 16 * nt + fr; f32x4 re[2], im[2];
            if (STAGE == 1) { const int idx = (x * f) & 4095; const float cp = ct[idx], sp = st[idx];
#pragma unroll
                for (int mt = 0; mt < 2; ++mt) { re[mt] = acc[mt][nt] * cp + acc[mt][nt + 4] * sp; im[mt] = acc[mt][nt + 4] * cp - acc[mt][nt] * sp; } }
            else {
#pragma unroll
                for (int mt = 0; mt < 2; ++mt) { re[mt] = acc[mt][nt]; im[mt] = acc[mt][nt + 4]; } }
            const u32x4 vr = (u32x4){pk2(re[0][0], re[0][1]), pk2(re[0][2], re[0][3]), pk2(re[1][0], re[1][1]), pk2(re[1][2], re[1][3])};
            const u32x4 vi = (u32x4){pk2(im[0][0], im[0][1]), pk2(im[0][2], im[0][3]), pk2(im[1][0], im[1][1]), pk2(im[1][2], im[1][3])};
            if (STAGE == 1) { bf16_t* o = dst + ((((size_t)(b * 64 + f) * 2) * 64 + x) * 1024) + colb;
                *(u32x4*)o = vr; *(u32x4*)(o + (size_t)64 * 1024) = vi; }
            else { bf16_t* o = dst + ((size_t)(b * SEQ + x + 64 * f)) * D + 512 * h + 32 * w + 8 * fq;
                *(u32x4*)o = vr; *(u32x4*)(o + 256) = vi; }
        }
        __syncthreads();
    }
}
__device__ __forceinline__ void pool_pass(const bf16_t* UB, bf16_t* MIXB, int gtid, int gthreads) {
    for (int idx = gtid; idx < NTOK * 128; idx += gthreads) {
        const int tok = idx >> 7, c8 = (idx & 127) * 8, g = c8 >> 8;
        const int b = tok / SEQ, t = tok % SEQ, k = 2 << g;
        int lo = t - (k - 1) / 2, hi = t + k / 2 + 1; lo = lo < 0 ? 0 : lo; hi = hi > SEQ ? SEQ : hi;
        float s[8];
#pragma unroll
        for (int j = 0; j < 8; ++j) s[j] = 0.f;
        for (int tt = lo; tt < hi; ++tt) { const u32x4 v = *(const u32x4*)(UB + ((size_t)(b * SEQ + tt)) * D + c8);
#pragma unroll
            for (int j = 0; j < 4; ++j) { s[2 * j] += __uint_as_float(v[j] << 16); s[2 * j + 1] += __uint_as_float(v[j] & 0xffff0000u); } }
        const u32x4 sv = *(const u32x4*)(UB + (size_t)tok * D + c8); const float inv = 1.0f / (float)(hi - lo); u32x4 o;
#pragma unroll
        for (int j = 0; j < 4; ++j) o[j] = pk2(s[2 * j] * inv - __uint_as_float(sv[j] << 16), s[2 * j + 1] * inv - __uint_as_float(sv[j] & 0xffff0000u));
        *(u32x4*)(MIXB + (size_t)tok * D + c8) = o;
    }
}
struct StoreT { bf16_t* p; const float* scale;
    __device__ void operator()(int z, int r, int n, float v) const { p[(size_t)(z * 256 + n) * D + r] = (bf16_t)f2bf(v * scale[z * 256 + n]); } };

struct TI { int tid, lane, wid, gtid, gwave; };
__device__ __forceinline__ TI ti() { int t = threadIdx.x; asm volatile("" : "+v"(t)); TI r; r.tid = t; r.lane = t & 63; r.wid = t >> 6; r.gtid = blockIdx.x * NTHR + t; r.gwave = blockIdx.x * NWAVE + (t >> 6); return r; }

__global__ __launch_bounds__(NTHR, 2) void mega(Params p) {
    extern __shared__ __attribute__((aligned(16))) unsigned char lds_raw[];
    LAS unsigned char* lds = (LAS unsigned char*)lds_raw;
    lds_tile_t As = (lds_tile_t)(lds); lds_tile_t Bs = (lds_tile_t)(lds + 256 * 40 * 2);
    cg::grid_group grid = cg::this_grid();
    const int gthreads = gridDim.x * NTHR, gwaves = gridDim.x * NWAVE;
    char* ws = p.ws; float* out = p.out;
    bf16_t* HB = (bf16_t*)(ws + 0 * MiB);
    bf16_t* WTIN = (bf16_t*)(ws + 64 * MiB);
    bf16_t* WTOUT = (bf16_t*)(ws + 72 * MiB);
    char* sm = ws + 80 * MiB;
    bf16_t* MT = (bf16_t*)(ws + 84 * MiB);
    bf16_t* WGU = (bf16_t*)(ws + 96 * MiB);
    bf16_t* WDN = (bf16_t*)(ws + 160 * MiB);
    bf16_t* UB = (bf16_t*)(ws + 192 * MiB);
    bf16_t* B1 = (bf16_t*)(ws + 256 * MiB);
    bf16_t* YA = (bf16_t*)(ws + 320 * MiB);
    bf16_t* MIXB = (bf16_t*)(ws + 384 * MiB);
    bf16_t* YD = (bf16_t*)(ws + 192 * MiB);
    bf16_t* ACT = (bf16_t*)(ws + 320 * MiB);
    float* ct = (float*)(sm); float* st = (float*)(sm + 16384);
    int* cnt = (int*)(sm + 32768); int* off = cnt + 64; int* cur = cnt + 128;
    int* tok_e = (int*)(sm + 65536); float* tok_w = (float*)(sm + 65536 + 131072);
    int* list = (int*)(sm + 65536 + 2 * 131072); int* tpos = (int*)(sm + 65536 + 3 * 131072); float* pw = (float*)(sm + 65536 + 4 * 131072);
    bf16_t* TAB1 = (bf16_t*)(sm + 1 * MiB); bf16_t* TAB2 = (bf16_t*)(sm + 1 * MiB + 32768);
    LAS unsigned* rowtab = (LAS unsigned*)(lds + 131072);
    f32x4 v[8];

    { const TI T = ti(); const int tid = T.tid, lane = T.lane, wid = T.wid, gtid = T.gtid, gwave = T.gwave; (void)tid; (void)lane; (void)wid; (void)gtid; (void)gwave;
    for (int i = gtid; i < 4096; i += gthreads) { ct[i] = cospif((float)i / 2048.0f); st[i] = sinpif((float)i / 2048.0f); }
    if (gtid < 192) cnt[gtid] = 0;
    dft_make_tables(TAB1, TAB2, gtid, gthreads);
    { LAS float* c256 = (LAS float*)(lds + 139264); if (tid < 256) { c256[tid] = cospif((float)tid / 128.0f); c256[256 + tid] = sinpif((float)tid / 128.0f); }
      __syncthreads();
      for (int i = gtid; i < 4 * 512 * 256; i += gthreads) { const int e = i & 255, kk = (i >> 8) & 511, h = i >> 17, j = kk & 255; const LAS float* tb = c256 + (kk < 256 ? 0 : 256);
          float a = 0.f;
          for (int m = 0; m < 256; ++m) a += tb[(j * m) & 255] * p.w_fourier[((size_t)h * 256 + m) * 256 + e];
          MT[((size_t)h * 256 + e) * 512 + kk] = (bf16_t)f2bf(a * (1.0f / 1024.0f)); }
      __syncthreads(); }
    { LdA a{p.w_in, D, 0, GD}; LdB b{p.w_pool, GD, (long)GD * GD, 0}; EpEl<StoreT> e{{WTIN, p.pool_scale}};
      sgemm_phase(a, b, e, GD, GD / 128, D / 256, 4, As, Bs); }
    { LAS float* scr = (LAS float*)(lds + wid * 16384);
      constexpr int I_WI = (D / 64) * (FW / 32), I_W = (D / 64) * (D / 32), I_E = 512, NIT = I_WI + I_W + NE * 3 * I_E;
      for (int it = gwave; it < NIT; it += gwaves) {
          if (it < I_WI) { const int n0 = 1024 + 32 * (it % 32); transpose_item(p.w_in, D, 64 * (it / 32), n0, WTIN + (size_t)n0 * D, D, scr, lane); continue; }
          if (it < I_WI + I_W) { const int r = it - I_WI; transpose_item(p.w_out, D, 64 * (r / 64), 32 * (r % 64), WTOUT + (size_t)(32 * (r % 64)) * D, D, scr, lane); continue; }
          const int r = it - I_WI - I_W, e = r / (3 * I_E), q = (r % (3 * I_E)) / I_E, j = r % I_E;
          if (q < 2) { const int k0 = 64 * (j / 16), n0 = 32 * (j % 16); const float* W = (q == 0 ? p.w_gate : p.w_up) + (size_t)e * D * FF;
              transpose_item(W, FF, k0, n0, WGU + ((size_t)e * 1024 + (n0 >> 7) * 256 + (n0 & 127) + q * 128) * D, D, scr, lane); }
          else { const int k0 = 64 * (j / 64), n0 = 32 * (j % 64);
              transpose_item(p.w_down + (size_t)e * FF * D, D, k0, n0, WDN + ((size_t)e * D + n0) * FF, FF, scr, lane); }
      } }
    for (int row = gwave; row < NTOK; row += gwaves) rms_row(p.x, p.g_mix, nullptr, HB, row, lane, nullptr, nullptr, v);
    }
    grid.sync();
    { const TI T = ti(); const int tid = T.tid, lane = T.lane, wid = T.wid, gtid = T.gtid, gwave = T.gwave; (void)tid; (void)lane; (void)wid; (void)gtid; (void)gwave;
    { PolBf16 S; S.init(NTOK / 256, D / 256, gridDim.x, blockIdx.x); S.K = D; S.A = HB; S.Bt = WTIN; S.C = UB; S.lda_b = D * 2; S.acol_b = 0; S.ldc = D; S.ccol0 = 0;
      pg8::gemm_phase(lds, S); }
    }
    grid.sync();
    { const TI T = ti(); const int tid = T.tid, lane = T.lane, wid = T.wid, gtid = T.gtid, gwave = T.gwave; (void)tid; (void)lane; (void)wid; (void)gtid; (void)gwave;
    dft_pass<1>(lds, UB, B1, TAB1, ct, st);
    pool_pass(UB, MIXB, gtid, gthreads);
    }
    grid.sync();
    { const TI T = ti(); const int tid = T.tid, lane = T.lane, wid = T.wid, gtid = T.gtid, gwave = T.gwave; (void)tid; (void)lane; (void)wid; (void)gtid; (void)gwave;
    dft_pass<2>(lds, B1, YA, TAB2, ct, st);
    }
    grid.sync();
    { const TI T = ti(); const int tid = T.tid, lane = T.lane, wid = T.wid, gtid = T.gtid, gwave = T.gwave; (void)tid; (void)lane; (void)wid; (void)gtid; (void)gwave;
    { PolBf16 S; S.init(NTOK / 256, 4, gridDim.x, blockIdx.x); S.K = 512; S.A = YA; S.Bt = MT; S.C = MIXB; S.lda_b = D * 2; S.acol_b = 1024; S.ldc = D; S.ccol0 = 1024;
      pg8::gemm_phase(lds, S); }
    }
    grid.sync();
    { const TI T = ti(); const int tid = T.tid, lane = T.lane, wid = T.wid, gtid = T.gtid, gwave = T.gwave; (void)tid; (void)lane; (void)wid; (void)gtid; (void)gwave;
    { PolGemmOut S; S.init(NTOK / 256, D / 256, gridDim.x, blockIdx.x); S.K = D; S.A = MIXB; S.Bt = WTOUT; S.C = out; S.X = p.x;
      pg8::gemm_phase(lds, S); }
    }
    grid.sync();
    { const TI T = ti(); const int tid = T.tid, lane = T.lane, wid = T.wid, gtid = T.gtid, gwave = T.gwave; (void)tid; (void)lane; (void)wid; (void)gtid; (void)gwave;
    for (int row = gwave; row < NTOK; row += gwaves) { rms_row(out, p.g_ffn, nullptr, HB, row, lane, nullptr, nullptr, v); router_row(v, row, lane, p.wgr, p.bgr, p.wer, p.ber, tok_e, tok_w, cnt); }
    }
    grid.sync();
    { const TI T = ti(); const int tid = T.tid, lane = T.lane, wid = T.wid, gtid = T.gtid, gwave = T.gwave; (void)tid; (void)lane; (void)wid; (void)gtid; (void)gwave;
    { int offl[NE]; int s = 0;
#pragma unroll
      for (int e = 0; e < NE; ++e) { offl[e] = s; s += cnt[e]; }
      if (gtid < NE) { int o = 0; for (int e = 0; e < gtid; ++e) o += cnt[e]; off[gtid] = o; }
      for (int i = gtid; i < 2 * NTOK; i += gthreads) {
          const int e = tok_e[i]; int o = 0;
#pragma unroll
          for (int q = 0; q < NE; ++q) o = (q == e) ? offl[q] : o;
          const int pos = o + atomicAdd(&cur[e], 1);
          list[pos] = i >> 1; tpos[i] = pos; pw[pos] = tok_w[i]; } }
    }
    grid.sync();
    { const TI T = ti(); const int tid = T.tid, lane = T.lane, wid = T.wid, gtid = T.gtid, gwave = T.gwave; (void)tid; (void)lane; (void)wid; (void)gtid; (void)gwave;
    { PolMoeUp S; S.init(4, gridDim.x, blockIdx.x, cnt); S.K = D; S.A = HB; S.Bt = WGU; S.ACT = ACT; S.pw = pw; S.rowtab = rowtab;
      pg8::Unit u;
      for (int i = 0; i < 8; ++i) { if (!S.next(i, u)) break;
          if (tid < 256) { const int rr = tid < u.nrows ? tid : u.nrows - 1; rowtab[i * 256 + tid] = (unsigned)list[u.rowbase + rr] * (unsigned)(D * 2); } }
      __syncthreads();
      pg8::gemm_phase(lds, S); }
    }
    grid.sync();
    { const TI T = ti(); const int tid = T.tid, lane = T.lane, wid = T.wid, gtid = T.gtid, gwave = T.gwave; (void)tid; (void)lane; (void)wid; (void)gtid; (void)gwave;
    { PolMoeDown S; S.init(8, gridDim.x, blockIdx.x, cnt); S.K = FF; S.A = ACT; S.Bt = WDN; S.YD = YD;
      pg8::gemm_phase(lds, S); }
    }
    grid.sync();
    { const TI T = ti(); const int tid = T.tid, lane = T.lane, wid = T.wid, gtid = T.gtid, gwave = T.gwave; (void)tid; (void)lane; (void)wid; (void)gtid; (void)gwave;
    for (int row = gwave; row < NTOK; row += gwaves) rms_row(out, p.g_final, out, nullptr, row, lane, YD, tpos, v);
    }
}

extern "C" void kernel_launch(void* const* d_in, const int* in_sizes, int n_in, void* d_out, int out_size, void* d_ws, size_t ws_size, hipStream_t stream) {
    static int grid_blocks = 0;
    if (!grid_blocks) {
        int dev = 0, cus = 0, per_cu = 0;
        (void)hipGetDevice(&dev);
        (void)hipDeviceGetAttribute(&cus, hipDeviceAttributeMultiprocessorCount, dev);
        (void)hipFuncSetAttribute((const void*)mega, hipFuncAttributeMaxDynamicSharedMemorySize, LDS_BYTES);
        (void)hipOccupancyMaxActiveBlocksPerMultiprocessor(&per_cu, mega, NTHR, LDS_BYTES);
        if (per_cu > 1) per_cu = 1;
        grid_blocks = cus * per_cu;
    }
    if (ws_size < 512 * MiB || grid_blocks <= 0) { fprintf(stderr, "workspace too small or no occupancy\n"); return; }
    Params p{};
    p.x = (const float*)d_in[0]; p.g_mix = (const float*)d_in[1]; p.w_in = (const float*)d_in[2]; p.w_pool = (const float*)d_in[3];
    p.pool_scale = (const float*)d_in[4]; p.w_fourier = (const float*)d_in[5]; p.w_out = (const float*)d_in[6]; p.g_ffn = (const float*)d_in[7];
    p.wgr = (const float*)d_in[8]; p.bgr = (const float*)d_in[9]; p.wer = (const float*)d_in[10]; p.ber = (const float*)d_in[11];
    p.w_gate = (const float*)d_in[12]; p.w_up = (const float*)d_in[13]; p.w_down = (const float*)d_in[14]; p.g_final = (const float*)d_in[15];
    p.out = (float*)d_out; p.ws = (char*)d_ws;
    void* args[] = {&p};
    hipError_t e = hipLaunchCooperativeKernel((void*)mega, dim3(grid_blocks), dim3(NTHR), args, LDS_BYTES, stream);
    if (e != hipSuccess) fprintf(stderr, "cooperative launch failed: %s (grid %d)\n", hipGetErrorString(e), grid_blocks);
}
```

```cpp
#include <hip/hip_runtime.h>
#include <stdint.h>
#include <stdio.h>
#include <hip/hip_cooperative_groups.h>
namespace cg = cooperative_groups;

typedef unsigned short bf16_t;
typedef short bf16x8 __attribute__((ext_vector_type(8)));
typedef float f32x4 __attribute__((ext_vector_type(4)));
typedef unsigned u32x4 __attribute__((ext_vector_type(4)));
typedef unsigned u32x2 __attribute__((ext_vector_type(2)));
#define LAS __attribute__((address_space(3)))

constexpr int D = 2048, BATCH = 4, SEQ = 4096, NTOK = BATCH * SEQ;
constexpr int PW = 1024, FW = 1024, GD = 256, NE = 16, FF = 512;
constexpr float EPS = 1e-6f;
constexpr int NTHR = 512, NWAVE = 8;
constexpr int LDS_BYTES = 147456;
constexpr size_t MiB = 1u << 20;
constexpr size_t BAR_OFF = 82 * MiB;

__device__ __forceinline__ unsigned f2bf(float f) { unsigned u = __float_as_uint(f); return (u + 0x7fffu + ((u >> 16) & 1u)) >> 16; }
__device__ __forceinline__ unsigned pk2(float lo, float hi) { return f2bf(lo) | (f2bf(hi) << 16); }
__device__ __forceinline__ float bf2f(unsigned short b) { return __uint_as_float(((unsigned)b) << 16); }
__device__ __forceinline__ float wave_sum(float v) {
#pragma unroll
    for (int o = 1; o < 64; o <<= 1) v += __shfl_xor(v, o);
    return v;
}

namespace pg8 {
constexpr int BM = 256, BK = 64, HALF = 128, HTB = HALF * BK * 2, STAGE_BYTES = 8 * HTB, NXCD = 8, WGM = 8;
__host__ __device__ __forceinline__ int lds_byte(int r, int c) { const int st = (r >> 4) * 2 + (c >> 5), rr = r & 15, cc = c & 31, ob = rr * 64 + cc * 2; return st * 1024 + (ob ^ (((ob >> 9) & 1) << 5)); }
__host__ __device__ __forceinline__ void stage_rc(int b, int& R, int& C) { const int st = b / 1024, sb = b % 1024, swz = sb ^ (((sb >> 9) & 1) << 5); R = (st >> 1) * 16 + swz / 64; C = (st & 1) * 32 + (swz % 64) / 2; }

struct Unit { int pm, pn, g, idx, rowbase, nrows; };

struct GridOrder {
    int nM, nN, nwg, G, c;
    __device__ void init(int nM_, int nN_, int G_, int c_) { nM = nM_; nN = nN_; nwg = nM * nN; G = G_; c = c_; }
    __device__ bool next(int i, Unit& u) const {
        const long L = (long)i * G + c; if (L >= nwg) return false;
        int wgid = (int)L; { const int q = nwg / NXCD, r = nwg % NXCD, xcd = wgid % NXCD, off = wgid / NXCD; wgid = (xcd < r ? xcd * (q + 1) : r * (q + 1) + (xcd - r) * q) + off; }
        const int nig = WGM * nN, gid = wgid / nig, fm = gid * WGM, gsz = (nM - fm) < WGM ? (nM - fm) : WGM;
        u.pm = fm + ((wgid % nig) % gsz); u.pn = (wgid % nig) / gsz; u.g = 0; u.idx = i; u.rowbase = 0; u.nrows = 256; return true;
    }
};

template <class P>
__device__ __forceinline__ void gemm_phase(LAS unsigned char* lds, const P& S) {
    int tid_ = threadIdx.x; asm volatile("" : "+v"(tid_));
    const int tid = tid_, wid = __builtin_amdgcn_readfirstlane(tid >> 6), lane = tid & 63, wr = wid >> 2, wc = wid & 3, fr = lane & 15, fq = lane >> 4;
    const int K = S.K, nt = K / BK;
    int Rp[2], Cp[2]; unsigned voffB[2];
#pragma unroll
    for (int i = 0; i < 2; ++i) { stage_rc(tid * 16 + i * 8192, Rp[i], Cp[i]); voffB[i] = (unsigned)(Rp[i] * K + Cp[i]) * 2u; }
    const size_t kstep = (size_t)(BK * 2);
    const size_t hstepB = (size_t)HALF * K * 2;
    const unsigned ldsw = (unsigned)wid * 1024u;
    const int aoff = lds_byte(wr * 64 + fr, fq * 8), boff = lds_byte(wc * 32 + fr, fq * 8);
#define PG8_SA(b, h) (((b) * 2 + (h)) * HTB)
#define PG8_SB(b, h) ((4 + (b) * 2 + (h)) * HTB)
#define PG8_STAGE(bufoff, gbase, voff) do { _Pragma("unroll") for (int _i = 0; _i < 2; ++_i) \
        __builtin_amdgcn_global_load_lds((const unsigned*)((const char*)(gbase) + (voff)[_i]), (LAS unsigned*)(lds + (bufoff) + ldsw + _i * 8192), 16, 0, 0); } while (0)
#define PG8_LDA(dst, b, h) do { _Pragma("unroll") for (int m = 0; m < 4; ++m) _Pragma("unroll") for (int k = 0; k < 2; ++k) dst[m][k] = *(const LAS bf16x8*)(lds + PG8_SA(b, h) + aoff + m * 2048 + k * 1024); } while (0)
#define PG8_LDB(dst, b, h) do { _Pragma("unroll") for (int n = 0; n < 2; ++n) _Pragma("unroll") for (int k = 0; k < 2; ++k) dst[n][k] = *(const LAS bf16x8*)(lds + PG8_SB(b, h) + boff + n * 2048 + k * 1024); } while (0)
#define PG8_MMA(ai, bj, At, Bt) do { __builtin_amdgcn_s_setprio(1); _Pragma("unroll") for (int m = 0; m < 4; ++m) _Pragma("unroll") for (int n = 0; n < 2; ++n) _Pragma("unroll") for (int k = 0; k < 2; ++k) \
        acc[ai][bj][m][n] = __builtin_amdgcn_mfma_f32_16x16x32_bf16(Bt[n][k], At[m][k], acc[ai][bj][m][n], 0, 0, 0); __builtin_amdgcn_s_setprio(0); } while (0)
#define PG8_WAIT_V(n) asm volatile("s_waitcnt vmcnt(" #n ")" ::: "memory")
#define PG8_WAIT_L(n) asm volatile("s_waitcnt lgkmcnt(" #n ")" ::: "memory")
#define PG8_BAR __builtin_amdgcn_s_barrier()
#define PG8_SCHED __builtin_amdgcn_sched_barrier(0)
    Unit cur, nxt; int ui = 0;
    if (!S.next(0, cur)) return;
    f32x4 acc[2][2][4][2];
#pragma unroll
    for (int a = 0; a < 2; ++a)
#pragma unroll
        for (int b = 0; b < 2; ++b)
#pragma unroll
            for (int m = 0; m < 4; ++m)
#pragma unroll
                for (int n = 0; n < 2; ++n) acc[a][b][m][n] = (f32x4){0.f, 0.f, 0.f, 0.f};
    bf16x8 At[4][2], B0[2][2], B1[2][2];
    const char* const aB = S.a_base();
    unsigned oc0[2], oc1[2];
#pragma unroll
    for (int i = 0; i < 2; ++i) { oc0[i] = S.a_row_off(cur, Rp[i]) + (unsigned)Cp[i] * 2u; oc1[i] = S.a_row_off(cur, HALF + Rp[i]) + (unsigned)Cp[i] * 2u; }
    const char* cB = S.b_tile(cur);
    PG8_STAGE(PG8_SB(0, 0), cB, voffB); PG8_STAGE(PG8_SB(0, 1), cB + hstepB, voffB); PG8_STAGE(PG8_SA(0, 0), aB, oc0); PG8_STAGE(PG8_SA(0, 1), aB, oc1);
    if (wr == 1) PG8_BAR;
    PG8_WAIT_V(2); PG8_BAR;
    PG8_STAGE(PG8_SB(1, 0), cB + kstep, voffB); PG8_STAGE(PG8_SA(1, 0), aB + kstep, oc0); PG8_STAGE(PG8_SB(1, 1), cB + hstepB + kstep, voffB);
    PG8_WAIT_V(6); PG8_BAR;
    for (;;) {
        const bool has_next = S.next(ui + 1, nxt);
        unsigned on0[2], on1[2];
#pragma unroll
        for (int i = 0; i < 2; ++i) { on0[i] = has_next ? S.a_row_off(nxt, Rp[i]) + (unsigned)Cp[i] * 2u : oc0[i]; on1[i] = has_next ? S.a_row_off(nxt, HALF + Rp[i]) + (unsigned)Cp[i] * 2u : oc1[i]; }
        const char* nB = has_next ? S.b_tile(nxt) : cB;
        for (int t = 0; t < nt; t += 2) {
            const bool last = (t == nt - 2);
            const char* a1 = aB + (size_t)(t + 1) * kstep;
            const char* a2 = last ? aB : aB + (size_t)(t + 2) * kstep; const char* b2 = last ? nB : cB + (size_t)(t + 2) * kstep;
            const char* a3 = a2 + kstep; const char* b3 = b2 + kstep;
            unsigned o20[2], o21[2];
#pragma unroll
            for (int i = 0; i < 2; ++i) { o20[i] = last ? on0[i] : oc0[i]; o21[i] = last ? on1[i] : oc1[i]; }
            PG8_LDB(B0, 0, 0); PG8_LDB(B1, 0, 1); PG8_SCHED; PG8_LDA(At, 0, 0); PG8_STAGE(PG8_SA(1, 1), a1, oc1);
            PG8_WAIT_V(8); PG8_WAIT_L(0); PG8_BAR; PG8_MMA(0, 0, At, B0); PG8_MMA(0, 1, At, B1); PG8_BAR; PG8_SCHED;
            PG8_LDA(At, 0, 1); PG8_STAGE(PG8_SB(0, 0), b2, voffB); PG8_STAGE(PG8_SB(0, 1), b2 + hstepB, voffB); PG8_STAGE(PG8_SA(0, 0), a2, o20);
            PG8_WAIT_V(8); PG8_WAIT_L(0); PG8_BAR; PG8_MMA(1, 0, At, B0); PG8_MMA(1, 1, At, B1); PG8_BAR; PG8_SCHED;
            PG8_LDB(B0, 1, 0); PG8_LDB(B1, 1, 1); PG8_SCHED; PG8_LDA(At, 1, 0); PG8_STAGE(PG8_SA(0, 1), a2, o21);
            PG8_WAIT_V(8); PG8_WAIT_L(0); PG8_BAR; PG8_MMA(0, 0, At, B0); PG8_MMA(0, 1, At, B1); PG8_BAR; PG8_SCHED;
            PG8_LDA(At, 1, 1); PG8_STAGE(PG8_SB(1, 0), b3, voffB); PG8_STAGE(PG8_SB(1, 1), b3 + hstepB, voffB); PG8_STAGE(PG8_SA(1, 0), a3, o20);
            PG8_WAIT_V(8); PG8_WAIT_L(0); PG8_BAR; PG8_MMA(1, 0, At, B0); PG8_MMA(1, 1, At, B1); PG8_BAR; PG8_SCHED;
        }
        if (wr == 0) PG8_BAR;
        S.epi(acc, cur, wr, wc, fr, fq);
        if (!has_next) break;
#pragma unroll
        for (int a = 0; a < 2; ++a)
#pragma unroll
            for (int b = 0; b < 2; ++b)
#pragma unroll
                for (int m = 0; m < 4; ++m)
#pragma unroll
                    for (int n = 0; n < 2; ++n) acc[a][b][m][n] = (f32x4){0.f, 0.f, 0.f, 0.f};
        cur = nxt; cB = nB; ++ui;
#pragma unroll
        for (int i = 0; i < 2; ++i) { oc0[i] = on0[i]; oc1[i] = on1[i]; }
        if (wr == 1) PG8_BAR;
    }
    PG8_WAIT_V(0);
    PG8_BAR;
#undef PG8_SA
#undef PG8_SB
#undef PG8_STAGE
#undef PG8_LDA
#undef PG8_LDB
#undef PG8_MMA
#undef PG8_WAIT_V
#undef PG8_WAIT_L
#undef PG8_BAR
#undef PG8_SCHED
}
}

struct PolBf16 : pg8::GridOrder {
    int K; const bf16_t* A; const bf16_t* Bt; bf16_t* C; int lda_b, acol_b, ldc, ccol0;
    __device__ const char* a_base() const { return (const char*)A; }
    __device__ unsigned a_row_off(const pg8::Unit& u, int r) const { return (unsigned)(u.pm * 256 + r) * (unsigned)lda_b + (unsigned)(u.pn * acol_b); }
    __device__ const char* b_tile(const pg8::Unit& u) const { return (const char*)Bt + (size_t)u.pn * 256 * K * 2; }
    __device__ void epi(const f32x4 (&acc)[2][2][4][2], const pg8::Unit& u, int wr, int wc, int fr, int fq) const {
        const int row0 = u.pm * 256 + wr * 64 + fr, col0 = ccol0 + u.pn * 256 + wc * 32 + 4 * fq;
#pragma unroll
        for (int ai = 0; ai < 2; ++ai)
#pragma unroll
            for (int m = 0; m < 4; ++m) { bf16_t* rowp = C + (size_t)(row0 + ai * 128 + m * 16) * ldc + col0;
#pragma unroll
                for (int bj = 0; bj < 2; ++bj)
#pragma unroll
                    for (int n = 0; n < 2; ++n) { const f32x4 a = acc[ai][bj][m][n]; *(u32x2*)(rowp + bj * 128 + n * 16) = (u32x2){pk2(a[0], a[1]), pk2(a[2], a[3])}; } }
    }
};
struct PolGemmOut : pg8::GridOrder {
    int K; const bf16_t* A; const bf16_t* Bt; float* C; const float* X;
    __device__ const char* a_base() const { return (const char*)A; }
    __device__ unsigned a_row_off(const pg8::Unit& u, int r) const { return (unsigned)(u.pm * 256 + r) * (unsigned)(K * 2); }
    __device__ const char* b_tile(const pg8::Unit& u) const { return (const char*)Bt + (size_t)u.pn * 256 * K * 2; }
    __device__ void epi(const f32x4 (&acc)[2][2][4][2], const pg8::Unit& u, int wr, int wc, int fr, int fq) const {
        const int row0 = u.pm * 256 + wr * 64 + fr, col0 = u.pn * 256 + wc * 32 + 4 * fq;
#pragma unroll
        for (int ai = 0; ai < 2; ++ai)
#pragma unroll
            for (int m = 0; m < 4; ++m) { const size_t o = (size_t)(row0 + ai * 128 + m * 16) * D + col0;
#pragma unroll
                for (int bj = 0; bj < 2; ++bj)
#pragma unroll
                    for (int n = 0; n < 2; ++n) *(f32x4*)(C + o + bj * 128 + n * 16) = acc[ai][bj][m][n] + *(const f32x4*)(X + o + bj * 128 + n * 16); }
    }
};


struct MoeOrder {
    int nN, rtx, xcd, slot, G; const int* cnt;
    __device__ void init(int nN_, int G_, int c_, const int* cnt_) { nN = nN_; G = G_; xcd = c_ & 7; slot = c_ >> 3; rtx = (G_ >> 3) / nN_; cnt = cnt_; }
    __device__ bool next(int i, pg8::Unit& u) const {
        const int rt = (i * 8 + xcd) * rtx + slot % rtx; u.pn = slot / rtx; u.idx = i;
        int acc_t = 0, acc_r = 0; bool found = false; u.pm = 0; u.g = 0; u.rowbase = 0; u.nrows = 0;
        for (int e = 0; e < NE; ++e) { const int c = cnt[e], nt_e = (c + 255) >> 8;
            if (!found && rt < acc_t + nt_e) { found = true; u.g = e; u.pm = rt - acc_t; u.rowbase = acc_r + u.pm * 256; const int rem = c - u.pm * 256; u.nrows = rem < 256 ? rem : 256; }
            acc_t += nt_e; acc_r += c; }
        return found;
    }
};
__device__ __forceinline__ float silu_f(float g) { return g / (1.f + __expf(-g)); }
struct PolMoeUp : MoeOrder {
    int K; const bf16_t* A; const bf16_t* Bt; bf16_t* ACT; const float* pw; const LAS unsigned* rowtab;
    __device__ const char* a_base() const { return (const char*)A; }
    __device__ unsigned a_row_off(const pg8::Unit& u, int r) const { return rowtab[u.idx * 256 + r]; }
    __device__ const char* b_tile(const pg8::Unit& u) const { return (const char*)Bt + ((size_t)u.g * 1024 + (size_t)u.pn * 256) * K * 2; }
    __device__ void epi(const f32x4 (&acc)[2][2][4][2], const pg8::Unit& u, int wr, int wc, int fr, int fq) const {
#pragma unroll
        for (int ai = 0; ai < 2; ++ai)
#pragma unroll
            for (int m = 0; m < 4; ++m) { const int r = ai * 128 + wr * 64 + m * 16 + fr; if (r >= u.nrows) continue;
                const size_t pos = (size_t)u.rowbase + r; const float w = pw[pos];
#pragma unroll
                for (int n = 0; n < 2; ++n) { const f32x4 g = acc[ai][0][m][n], v = acc[ai][1][m][n];
                    const int f = u.pn * 128 + wc * 32 + n * 16 + fq * 4;
                    *(u32x2*)(ACT + pos * FF + f) = (u32x2){pk2(silu_f(g[0]) * v[0] * w, silu_f(g[1]) * v[1] * w), pk2(silu_f(g[2]) * v[2] * w, silu_f(g[3]) * v[3] * w)}; } }
    }
};
struct PolMoeDown : MoeOrder {
    int K; const bf16_t* A; const bf16_t* Bt; bf16_t* YD;
    __device__ const char* a_base() const { return (const char*)A; }
    __device__ unsigned a_row_off(const pg8::Unit& u, int r) const { const int rr = r < u.nrows ? r : u.nrows - 1; return (unsigned)(u.rowbase + rr) * (unsigned)(K * 2); }
    __device__ const char* b_tile(const pg8::Unit& u) const { return (const char*)Bt + ((size_t)u.g * 2048 + (size_t)u.pn * 256) * K * 2; }
    __device__ void epi(const f32x4 (&acc)[2][2][4][2], const pg8::Unit& u, int wr, int wc, int fr, int fq) const {
#pragma unroll
        for (int ai = 0; ai < 2; ++ai)
#pragma unroll
            for (int m = 0; m < 4; ++m) { const int r = ai * 128 + wr * 64 + m * 16 + fr; if (r >= u.nrows) continue;
                bf16_t* rowp = YD + ((size_t)u.rowbase + r) * D + u.pn * 256 + wc * 32 + fq * 4;
#pragma unroll
                for (int bj = 0; bj < 2; ++bj)
#pragma unroll
                    for (int n = 0; n < 2; ++n) { const f32x4 a = acc[ai][bj][m][n]; *(u32x2*)(rowp + bj * 128 + n * 16) = (u32x2){pk2(a[0], a[1]), pk2(a[2], a[3])}; } }
    }
};

typedef bf16_t LAS (*lds_tile_t)[40];
template <class AL, class BL, class EP>
__device__ __forceinline__ void gemm_tile(const AL& al, const BL& bl, const EP& ep, const int K, const int bxi, const int byi, const int bz, lds_tile_t As, lds_tile_t Bs) {
    const int tid = threadIdx.x, wid = tid >> 6, lane = tid & 63;
    const int bm = byi * 256, bn = bxi * 128;
    const int wr = wid >> 1, wc = wid & 1;
    f32x4 acc[4][4];
#pragma unroll
    for (int m = 0; m < 4; ++m)
#pragma unroll
        for (int n = 0; n < 4; ++n) acc[m][n] = (f32x4){0.f, 0.f, 0.f, 0.f};
    for (int k0 = 0; k0 < K; k0 += 32) {
#pragma unroll
        for (int i = 0; i < 4; ++i) {
            const int row = (tid >> 3) + 64 * i, kk = (tid & 7) * 4;
            const float4 v = al.load4(bz, bm + row, k0 + kk);
            *(LAS u32x2*)&As[row][kk] = (u32x2){pk2(v.x, v.y), pk2(v.z, v.w)};
        }
#pragma unroll
        for (int i = 0; i < 2; ++i) {
            const int k = (tid >> 5) + 16 * i, n = (tid & 31) * 4;
            const float4 v = bl.load4(bz, k0 + k, bn + n, n);
            Bs[n + 0][k] = (bf16_t)f2bf(v.x); Bs[n + 1][k] = (bf16_t)f2bf(v.y); Bs[n + 2][k] = (bf16_t)f2bf(v.z); Bs[n + 3][k] = (bf16_t)f2bf(v.w);
        }
        __syncthreads();
        bf16x8 a[4], b[4];
#pragma unroll
        for (int m = 0; m < 4; ++m) a[m] = *(const LAS bf16x8*)&As[wr * 64 + m * 16 + (lane & 15)][(lane >> 4) * 8];
#pragma unroll
        for (int n = 0; n < 4; ++n) b[n] = *(const LAS bf16x8*)&Bs[wc * 64 + n * 16 + (lane & 15)][(lane >> 4) * 8];
#pragma unroll
        for (int m = 0; m < 4; ++m)
#pragma unroll
            for (int n = 0; n < 4; ++n) acc[m][n] = __builtin_amdgcn_mfma_f32_16x16x32_bf16(a[m], b[n], acc[m][n], 0, 0, 0);
        __syncthreads();
    }
    ep(bz, bm, bn, wr, wc, lane, acc);
}
template <class AL, class BL, class EP>
__device__ __forceinline__ void sgemm_phase(const AL& al, const BL& bl, const EP& ep, int K, int nx, int ny, int nz, lds_tile_t As, lds_tile_t Bs) {
    const int total = nx * ny * nz;
    for (int t = blockIdx.x; t < total; t += gridDim.x) {
        const int bxi = t % nx, byi = (t / nx) % ny, bz = t / (nx * ny);
        if (!al.active(bz, byi * 256)) continue;
        gemm_tile(al, bl, ep, K, bxi, byi, bz, As, Bs);
    }
}

struct LdA { const float* p; long ld, zs; long coff_z;
    __device__ bool active(int, int) const { return true; }
    __device__ float4 load4(int z, int r, int c) const { return *(const float4*)(p + (long)z * zs + (long)r * ld + (long)z * coff_z + c); } };
struct LdB { const float* p; long ld, zs; long coff_z;
    __device__ float4 load4(int z, int k, int n, int) const { return *(const float4*)(p + (long)z * zs + (long)k * ld + (long)z * coff_z + n); } };
template <class F> struct EpEl { F f;
    __device__ void operator()(int z, int bm, int bn, int wr, int wc, int lane, const f32x4 (&acc)[4][4]) const {
#pragma unroll
        for (int m = 0; m < 4; ++m)
#pragma unroll
            for (int n = 0; n < 4; ++n)
#pragma unroll
                for (int r = 0; r < 4; ++r) f(z, bm + wr * 64 + m * 16 + (lane >> 4) * 4 + r, bn + wc * 64 + n * 16 + (lane & 15), acc[m][n][r]);
    } };
struct StoreF { float* p; long ld, zs; long coff_z; const float* scale;
    __device__ void operator()(int z, int r, int n, float v) const {
        const long o = (long)z * zs + (long)r * ld + (long)z * coff_z + n;
        if (scale) v *= scale[z * coff_z + n];
        p[o] = v; } };
struct StoreB { bf16_t* p; long ld, zs; long coff_z; const float* scale;
    __device__ void operator()(int z, int r, int n, float v) const {
        const long o = (long)z * zs + (long)r * ld + (long)z * coff_z + n;
        if (scale) v *= scale[z * coff_z + n];
        p[o] = (bf16_t)f2bf(v); } };
struct LdDftS { const float* ct; const float* st;
    __device__ bool active(int, int) const { return true; }
    __device__ float4 load4(int, int m, int s) const { const int k = m & 4095; const bool im = m >= 4096; float v[4];
#pragma unroll
        for (int j = 0; j < 4; ++j) { const int idx = (k * (s + j)) & 4095; v[j] = im ? -st[idx] : ct[idx]; }
        return make_float4(v[0], v[1], v[2], v[3]); } };
struct StoreY { float* yr; float* yi;
    __device__ void operator()(int z, int m, int n, float v) const { if (m < 4096) yr[((long)z * 4096 + m) * 1024 + n] = v; else yi[((long)z * 4096 + (m - 4096)) * 1024 + n] = v; } };
struct LdYri { const float* yr; const float* yi;
    __device__ bool active(int, int) const { return true; }
    __device__ float4 load4(int z, int r, int c) const { return c < 256 ? *(const float4*)(yr + (long)r * 1024 + z * 256 + c) : *(const float4*)(yi + (long)r * 1024 + z * 256 + c - 256); } };
struct LdDftD { const float* ct; const float* st;
    __device__ float4 load4(int, int k, int n, int) const { const int kk = k & 255; const bool s = k >= 256; float v[4];
#pragma unroll
        for (int j = 0; j < 4; ++j) { const int idx = ((kk * (n + j)) & 255) * 16; v[j] = (s ? st[idx] : ct[idx]) * (1.0f / 1024.0f); }
        return make_float4(v[0], v[1], v[2], v[3]); } };
struct LdGather { const float* p; long ld; const int* list; const int* off; const int* cnt;
    __device__ bool active(int z, int bm) const { return bm < cnt[z]; }
    __device__ float4 load4(int z, int r, int c) const { const bool ok = r < cnt[z]; const int t = list[off[z] + (ok ? r : 0)]; float4 v = *(const float4*)(p + (long)t * ld + c); const float m = ok ? 1.f : 0.f; v.x *= m; v.y *= m; v.z *= m; v.w *= m; return v; } };
struct LdRows { const float* p; long ld; const int* off; const int* cnt;
    __device__ bool active(int z, int bm) const { return bm < cnt[z]; }
    __device__ float4 load4(int z, int r, int c) const { const bool ok = r < cnt[z]; float4 v = *(const float4*)(p + (long)(off[z] + (ok ? r : 0)) * ld + c); const float m = ok ? 1.f : 0.f; v.x *= m; v.y *= m; v.z *= m; v.w *= m; return v; } };
struct LdGU { const float* wg; const float* wu;
    __device__ float4 load4(int z, int k, int n, int nl) const { const int bn = n - nl, wc = nl >> 6, t = (nl & 63) >> 4, c = nl & 15; const int f = (bn >> 1) + wc * 32 + (t & 1) * 16 + c;
        const long delta = (t < 2) ? 0l : (long)(wu - wg); return *(const float4*)(wg + delta + ((long)z * D + k) * FF + f); } };
struct EpGU { float* act; const int* off; const int* cnt; const float* pw;
    __device__ void operator()(int z, int bm, int bn, int wr, int wc, int lane, const f32x4 (&acc)[4][4]) const {
#pragma unroll
        for (int m = 0; m < 4; ++m)
#pragma unroll
            for (int t = 0; t < 2; ++t)
#pragma unroll
                for (int r = 0; r < 4; ++r) { const int row = bm + wr * 64 + m * 16 + (lane >> 4) * 4 + r; if (row >= cnt[z]) continue;
                    const int f = (bn >> 1) + wc * 32 + t * 16 + (lane & 15); const float g = acc[m][t][r], u = acc[m][t + 2][r];
                    const long pos = off[z] + row; act[pos * FF + f] = g / (1.f + __expf(-g)) * u * pw[pos]; }
    } };
struct EpDown { float* yd; const int* off; const int* cnt;
    __device__ void operator()(int z, int bm, int bn, int wr, int wc, int lane, const f32x4 (&acc)[4][4]) const {
#pragma unroll
        for (int m = 0; m < 4; ++m)
#pragma unroll
            for (int n = 0; n < 4; ++n)
#pragma unroll
                for (int r = 0; r < 4; ++r) { const int row = bm + wr * 64 + m * 16 + (lane >> 4) * 4 + r; if (row >= cnt[z]) continue;
                    yd[(long)(off[z] + row) * D + bn + wc * 64 + n * 16 + (lane & 15)] = acc[m][n][r]; }
    } };

struct Params {
    const float *x, *g_mix, *w_in, *w_pool, *pool_scale, *w_fourier, *w_out, *g_ffn, *wgr, *bgr, *wer, *ber, *w_gate, *w_up, *w_down, *g_final;
    float* out; char* ws;
};

__device__ __forceinline__ void transpose_item(const float* W, int ldw, int k0, int n0, bf16_t* dst, int dstK, LAS float* scr, int lane) {
#pragma unroll 8
    for (int i = 0; i < 32; ++i) { const int kk = 2 * i + (lane >> 5); scr[kk * 33 + (lane & 31)] = W[(size_t)(k0 + kk) * ldw + n0 + (lane & 31)]; }
    asm volatile("s_waitcnt lgkmcnt(0)" ::: "memory");
    const int c = lane & 7;
#pragma unroll
    for (int j = 0; j < 4; ++j) { const int n = (lane >> 3) + 8 * j; const LAS float* sp = scr + (8 * c) * 33 + n;
        u32x4 o; o.x = pk2(sp[0 * 33], sp[1 * 33]); o.y = pk2(sp[2 * 33], sp[3 * 33]); o.z = pk2(sp[4 * 33], sp[5 * 33]); o.w = pk2(sp[6 * 33], sp[7 * 33]);
        *(u32x4*)(dst + (size_t)n * dstK + k0 + 8 * c) = o; }
    asm volatile("s_waitcnt lgkmcnt(0)" ::: "memory");
}

__device__ __forceinline__ void rms_row(const float* x, const float* g, float* outf, bf16_t* outb, int row, int lane, const bf16_t* yd, const int* tpos, f32x4 (&v)[8]) {
    const f32x4* xr = (const f32x4*)(x + (long)row * D) + lane; float s = 0.f;
#pragma unroll
    for (int j = 0; j < 8; ++j) v[j] = xr[64 * j];
    if (yd) {
        const int p0 = tpos[2 * row], p1 = tpos[2 * row + 1];
        const u32x2* y0 = (const u32x2*)(yd + (long)p0 * D) + lane; const u32x2* y1 = (const u32x2*)(yd + (long)p1 * D) + lane;
#pragma unroll
        for (int j = 0; j < 8; ++j) { const u32x2 a = y0[64 * j], b = y1[64 * j];
            v[j].x += __uint_as_float(a.x << 16) + __uint_as_float(b.x << 16); v[j].y += __uint_as_float(a.x & 0xffff0000u) + __uint_as_float(b.x & 0xffff0000u);
            v[j].z += __uint_as_float(a.y << 16) + __uint_as_float(b.y << 16); v[j].w += __uint_as_float(a.y & 0xffff0000u) + __uint_as_float(b.y & 0xffff0000u); }
    }
#pragma unroll
    for (int j = 0; j < 8; ++j) s += (v[j].x * v[j].x + v[j].y * v[j].y) + (v[j].z * v[j].z + v[j].w * v[j].w);
    const float rstd = 1.0f / sqrtf(wave_sum(s) * (1.0f / D) + EPS);
    const f32x4* gr = (const f32x4*)g + lane;
#pragma unroll
    for (int j = 0; j < 8; ++j) v[j] = v[j] * rstd * gr[64 * j];
    if (outf) { f32x4* orow = (f32x4*)(outf + (long)row * D) + lane;
#pragma unroll
        for (int j = 0; j < 8; ++j) orow[64 * j] = v[j]; }
    if (outb) { u32x2* orow = (u32x2*)(outb + (long)row * D) + lane;
#pragma unroll
        for (int j = 0; j < 8; ++j) orow[64 * j] = (u32x2){pk2(v[j].x, v[j].y), pk2(v[j].z, v[j].w)}; }
}
__device__ __forceinline__ void router_row(const f32x4 (&v)[8], int row, int lane, const float* wgr, const float* bgr, const float* wer, const float* ber, int* tok_e, float* tok_w, int* cnt) {
    float acc[20];
#pragma unroll
    for (int j = 0; j < 20; ++j) acc[j] = 0.f;
#pragma unroll
    for (int j = 0; j < 8; ++j)
#pragma unroll
        for (int i = 0; i < 4; ++i) {
            const int d = 256 * j + 4 * lane + i; const float hv = v[j][i];
            const f32x4 wg = *(const f32x4*)(wgr + d * 4);
            acc[0] += hv * wg.x; acc[1] += hv * wg.y; acc[2] += hv * wg.z; acc[3] += hv * wg.w;
#pragma unroll
            for (int q = 0; q < 4; ++q) { const f32x4 we = *(const f32x4*)(wer + d * 16 + q * 4);
                acc[4 + q * 4 + 0] += hv * we.x; acc[4 + q * 4 + 1] += hv * we.y; acc[4 + q * 4 + 2] += hv * we.z; acc[4 + q * 4 + 3] += hv * we.w; }
        }
#pragma unroll
    for (int j = 0; j < 20; ++j) acc[j] = wave_sum(acc[j]);
    if (lane == 0) {
        float gl[4]; int gi = 0; float mx = -3.0e38f;
#pragma unroll
        for (int j = 0; j < 4; ++j) { gl[j] = acc[j] + bgr[j]; if (gl[j] > mx) { mx = gl[j]; gi = j; } }
        float se = 0.f;
#pragma unroll
        for (int j = 0; j < 4; ++j) se += __expf(gl[j] - mx);
        const float pg = 1.0f / se;
        float el[4];
#pragma unroll
        for (int j = 0; j < 4; ++j) { float t = 0.f;
#pragma unroll
            for (int q = 0; q < 4; ++q) t = (gi == q) ? acc[4 + q * 4 + j] + ber[q * 4 + j] : t;
            el[j] = t; }
        int i0 = 0; float v0 = el[0];
#pragma unroll
        for (int j = 1; j < 4; ++j) if (el[j] > v0) { v0 = el[j]; i0 = j; }
        int i1 = -1; float v1 = -3.0e38f;
#pragma unroll
        for (int j = 0; j < 4; ++j) if (j != i0 && el[j] > v1) { v1 = el[j]; i1 = j; }
        const float e1 = __expf(v1 - v0), inv = 1.0f / (1.0f + e1);
        const int ea = gi * 4 + i0, eb = gi * 4 + i1;
        tok_e[2 * row] = ea; tok_e[2 * row + 1] = eb; tok_w[2 * row] = pg * inv; tok_w[2 * row + 1] = pg * e1 * inv;
        atomicAdd(&cnt[ea], 1); atomicAdd(&cnt[eb], 1);
    }
}


typedef short s16x4 __attribute__((ext_vector_type(4)));
constexpr int DP = 544, DFT_TILE = 64 * DP, DFT_TAB_OFF = 2 * DFT_TILE;
__device__ __forceinline__ s16x4 tr16(const LAS unsigned char* p) { return __builtin_bit_cast(s16x4, __builtin_amdgcn_ds_read_tr16_b64_v4i16((LAS s16x4*)p)); }
__device__ __forceinline__ int dft_row_of_slot(int ks, int fq, int jj) { return 32 * ks + 16 * (jj >> 2) + 4 * fq + (jj & 3); }
__device__ __forceinline__ void dft_make_tables(bf16_t* t1, bf16_t* t2, int gtid, int gthreads) {
    for (int i = gtid; i < 2 * 8 * 64 * 8; i += gthreads) { const int jj = i & 7, l = (i >> 3) & 63, nt = (i >> 9) & 7, ks = i >> 12; const int fr = l & 15, fq = l >> 4;
        const int c = 16 * (nt & 3) + fr, a = dft_row_of_slot(ks, fq, jj); const float x = (float)((a * c) & 63) / 32.0f;
        t1[i] = (bf16_t)f2bf(nt < 4 ? cospif(x) : -sinpif(x)); }
    for (int i = gtid; i < 4 * 8 * 64 * 8; i += gthreads) { const int jj = i & 7, l = (i >> 3) & 63, nt = (i >> 9) & 7, ks = i >> 12; const int fr = l & 15, fq = l >> 4;
        const int d = 16 * (nt & 3) + fr, bp = dft_row_of_slot(ks & 1, fq, jj), part = ks >> 1; const float x = (float)((bp * d) & 63) / 32.0f;
        float v; if (nt < 4) v = part == 0 ? cospif(x) : sinpif(x); else v = part == 0 ? -sinpif(x) : cospif(x);
        t2[i] = (bf16_t)f2bf(v); }
}
template <int STAGE>
__device__ __forceinline__ void dft_pass(LAS unsigned char* lds, const bf16_t* src, bf16_t* dst, const bf16_t* tab, const float* ct, const float* st) {
    constexpr int NL = STAGE == 1 ? 4 : 8, NKS = STAGE == 1 ? 2 : 4;
    int tid_ = threadIdx.x; asm volatile("" : "+v"(tid_));
    const int tid = tid_, lane = tid & 63, w = __builtin_amdgcn_readfirstlane(tid >> 6), fr = lane & 15, fq = lane >> 4;
    const int G = gridDim.x, bx = blockIdx.x, vcu = (G % 8 == 0) ? (bx % 8) * (G / 8) + bx / 8 : bx;
    for (int i = tid; i < NKS * 8 * 64; i += NTHR) *(LAS u32x4*)(lds + DFT_TAB_OFF + i * 16) = *(const u32x4*)(tab + (size_t)i * 8);
    u32x4 pre[NL];
    auto unit_src = [&](int uid, int i) -> const bf16_t* {
        const int h = uid & 3, x = (uid >> 2) & 63, b = uid >> 8, idx = tid + NTHR * i, row = (idx >> 5) & 63, ch = idx & 31;
        if (STAGE == 1) return src + ((size_t)(b * SEQ + 64 * row + x)) * D + 1024 + 256 * h + ch * 8;
        const int part = idx >> 11; return src + ((((size_t)(b * 64 + x) * 2 + part) * 64 + row) * 1024) + 256 * h + ch * 8; };
    int uid = vcu;
    if (uid < 1024) {
#pragma unroll
        for (int i = 0; i < NL; ++i) pre[i] = *(const u32x4*)unit_src(uid, i); }
    for (; uid < 1024; uid += G) {
#pragma unroll
        for (int i = 0; i < NL; ++i) { const int idx = tid + NTHR * i, part = idx >> 11, row = (idx >> 5) & 63, ch = idx & 31; *(LAS u32x4*)(lds + part * DFT_TILE + row * DP + ch * 16) = pre[i]; }
        __syncthreads();
        if (uid + G < 1024) {
#pragma unroll
            for (int i = 0; i < NL; ++i) pre[i] = *(const u32x4*)unit_src(uid + G, i); }
        const int h = uid & 3, x = (uid >> 2) & 63, b = uid >> 8;
        f32x4 acc[2][8];
#pragma unroll
        for (int mt = 0; mt < 2; ++mt)
#pragma unroll
            for (int nt = 0; nt < 8; ++nt) acc[mt][nt] = (f32x4){0.f, 0.f, 0.f, 0.f};
#pragma unroll
        for (int ks = 0; ks < NKS; ++ks) {
            bf16x8 A[2];
#pragma unroll
            for (int mt = 0; mt < 2; ++mt) {
                const LAS unsigned char* base = lds + (ks >> 1) * DFT_TILE + (32 * (ks & 1) + 4 * fq + (fr >> 2)) * DP + (32 * w + 8 * (fr & 3) + 4 * mt) * 2;
                const s16x4 lo = tr16(base), hi = tr16(base + 16 * DP);
                A[mt] = (bf16x8){lo[0], lo[1], lo[2], lo[3], hi[0], hi[1], hi[2], hi[3]}; }
#pragma unroll
            for (int nt = 0; nt < 8; ++nt) { const bf16x8 B = *(const LAS bf16x8*)(lds + DFT_TAB_OFF + ((ks * 8 + nt) * 64 + lane) * 16);
#pragma unroll
                for (int mt = 0; mt < 2; ++mt) acc[mt][nt] = __builtin_amdgcn_mfma_f32_16x16x32_bf16(A[mt], B, acc[mt][nt], 0, 0, 0); }
        }
        const int colb = 256 * h + 32 * w + 8 * fq;
#pragma unroll
        for (int nt = 0; nt < 4; ++nt) {
            const int f = 16 * nt + fr; f32x4 re[2], im[2];
            if (STAGE == 1) { const int idx = (x * f) & 4095; const float cp = ct[idx], sp = st[idx];
#pragma unroll
                for (int mt = 0; mt < 2; ++mt) { re[mt] = acc[mt][nt] * cp + acc[mt][nt + 4] * sp; im[mt] = acc[mt][nt + 4] * cp - acc[mt][nt] * sp; } }
            else {
#pragma unroll
                for (int mt = 0; mt < 2; ++mt) { re[mt] = acc[mt][nt]; im[mt] = acc[mt][nt + 4]; } }
            const u32x4 vr = (u32x4){pk2(re[0][0], re[0][1]), pk2(re[0][2], re[0][3]), pk2(re[1][0], re[1][1]), pk2(re[1][2], re[1][3])};
            const u32x4 vi = (u32x4){pk2(im[0][0], im[0][1]), pk2(im[0][2], im[0][3]), pk2(im[1][0], im[1][1]), pk2(im[1][2], im[1][3])};
            if (STAGE == 1) { bf16_t* o = dst + ((((size_t)(b * 64 + f) * 2) * 64 + x) * 1024) + colb;
                *(u32x4*)o = vr; *(u32x4*)(o + (size_t)64 * 1024) = vi; }
            else { bf16_t* o = dst + ((size_t)(b * SEQ + x + 64 * f)) * D + 512 * h + 32 * w + 8 * fq;
                *(u32x4*)o = vr; *(u32x4*)(o + 256) = vi; }
        }
        __syncthreads();
    }
}
__device__ __forceinline__ void pool_pass(const bf16_t* UB, bf16_t* MIXB, int gtid, int gthreads) {
    for (int idx = gtid; idx < NTOK * 128; idx += gthreads) {
        const int tok = idx >> 7, c8 = (idx & 127) * 8, g = c8 >> 8;
        const int b = tok / SEQ, t = tok % SEQ, k = 2 << g;
        int lo = t - (k - 1) / 2, hi = t + k / 2 + 1; lo = lo < 0 ? 0 : lo; hi = hi > SEQ ? SEQ : hi;
        float s[8];
#pragma unroll
        for (int j = 0; j < 8; ++j) s[j] = 0.f;
        for (int tt = lo; tt < hi; ++tt) { const u32x4 v = *(const u32x4*)(UB + ((size_t)(b * SEQ + tt)) * D + c8);
#pragma unroll
            for (int j = 0; j < 4; ++j) { s[2 * j] += __uint_as_float(v[j] << 16); s[2 * j + 1] += __uint_as_float(v[j] & 0xffff0000u); } }
        const u32x4 sv = *(const u32x4*)(UB + (size_t)tok * D + c8); const float inv = 1.0f / (float)(hi - lo); u32x4 o;
#pragma unroll
        for (int j = 0; j < 4; ++j) o[j] = pk2(s[2 * j] * inv - __uint_as_float(sv[j] << 16), s[2 * j + 1] * inv - __uint_as_float(sv[j] & 0xffff0000u));
        *(u32x4*)(MIXB + (size_t)tok * D + c8) = o;
    }
}
struct StoreT { bf16_t* p; const float* scale;
    __device__ void operator()(int z, int r, int n, float v) const { p[(size_t)(z * 256 + n) * D + r] = (bf16_t)f2bf(v * scale[z * 256 + n]); } };


#define XB_TMO      128
#define XB_XCNT(j)  (256  + 64 * (j))
#define XB_XSUB(j)  (1280 + 64 * (j))
#define XB_XGEN(j)  (2304 + 64 * (j))
#define XB_TOP      3328
#define XB_TOPGEN   3392
#define XCD_BAR_WORDS 3456
#define XB_SPIN_CAP (1u << 22)
__device__ __forceinline__ unsigned xb_ld(unsigned* p)              { return __hip_atomic_load(p, __ATOMIC_RELAXED, __HIP_MEMORY_SCOPE_AGENT); }
__device__ __forceinline__ unsigned xb_add(unsigned* p, unsigned v) { return __hip_atomic_fetch_add(p, v, __ATOMIC_RELAXED, __HIP_MEMORY_SCOPE_AGENT); }
__device__ __forceinline__ unsigned xb_xcc_id() { return (unsigned)__builtin_amdgcn_s_getreg((3 << 11) | 20) & 0xFu; }
#define XB_SPIN(cond, bar) do { unsigned _sp = 0; while (cond) { __builtin_amdgcn_s_sleep(1); \
    if ((++_sp & 255u) == 0u) { if (xb_ld(&(bar)[XB_TMO])) break; if (_sp > XB_SPIN_CAP) { atomicAdd(&(bar)[XB_TMO], 1u); break; } } } } while (0)
struct XcdBarrier { unsigned* bar; unsigned x; volatile LAS unsigned* st; };
__device__ __forceinline__ XcdBarrier xcd_barrier_post(unsigned* bar, volatile LAS unsigned* st) {
    XcdBarrier b; b.bar = bar; b.x = xb_xcc_id(); b.st = st;
    if (threadIdx.x == 0) (void)xb_add(&bar[XB_XCNT(b.x)], 1u);
    return b;
}
__device__ __forceinline__ void xcd_barrier_complete(unsigned* bar, unsigned x, unsigned& nloc, unsigned& nx) {
    const unsigned G = gridDim.x * gridDim.y * gridDim.z;
    unsigned sum, cnt, mine, sp = 0u;
    for (;;) {
        sum = 0u; cnt = 0u; mine = 0u;
#pragma unroll
        for (unsigned j = 0; j < 16; ++j) { const unsigned c = xb_ld(&bar[XB_XCNT(j)]); sum += c; cnt += (c > 0u) ? 1u : 0u; mine = (j == x) ? c : mine; }
        if (sum == G) break;
        __builtin_amdgcn_s_sleep(1);
        if ((++sp & 255u) == 0u) { if (xb_ld(&bar[XB_TMO])) break; if (sp > XB_SPIN_CAP) { atomicAdd(&bar[XB_TMO], 1u); break; } }
    }
    nloc = mine > 0u ? mine : 1u; nx = cnt > 0u ? cnt : 1u;
}
__device__ __forceinline__ void xcd_barrier(const XcdBarrier& b) {
    asm volatile("s_waitcnt vmcnt(0)" ::: "memory");
    __syncthreads();
    if (threadIdx.x == 0) {
        unsigned* bar = b.bar;
        __builtin_amdgcn_s_waitcnt(0);
        unsigned nloc = b.st[0], nx = b.st[1];
        if (nloc == 0u) { xcd_barrier_complete(bar, b.x, nloc, nx); b.st[0] = nloc; b.st[1] = nx; }
        const unsigned old = xb_add(&bar[XB_XSUB(b.x)], 1u);
        const unsigned gen = old / nloc;
        if (old + 1u == (gen + 1u) * nloc) {
            __builtin_amdgcn_fence(__ATOMIC_RELEASE, "agent");
            asm volatile("s_waitcnt vmcnt(0)" ::: "memory");
            const unsigned og = xb_add(&bar[XB_TOP], 1u);
            const unsigned tg = og / nx;
            if (og + 1u == (tg + 1u) * nx) xb_add(&bar[XB_TOPGEN], 1u);
            else XB_SPIN(xb_ld(&bar[XB_TOPGEN]) == tg, bar);
            __builtin_amdgcn_fence(__ATOMIC_ACQUIRE, "agent");
            xb_add(&bar[XB_XGEN(b.x)], 1u);
            asm volatile("s_waitcnt vmcnt(0)" ::: "memory");
        } else {
            XB_SPIN(xb_ld(&bar[XB_XGEN(b.x)]) == gen, bar);
            __builtin_amdgcn_fence(__ATOMIC_ACQUIRE, "agent");
            asm volatile("s_waitcnt vmcnt(0)" ::: "memory");
        }
    }
    __syncthreads();
}


__device__ __forceinline__ void router_phase(LAS unsigned char* lds, const float* x1, const float* g, const float* wgr, const float* bgr, const float* wer, const float* ber,
                                             bf16_t* HB, int* tok_e, float* tok_w, int* cnt) {
    int tid_ = threadIdx.x; asm volatile("" : "+v"(tid_));
    const int tid = tid_, lane = tid & 63, w = __builtin_amdgcn_readfirstlane(tid >> 6), fr = lane & 15, fq = lane >> 4;
    LAS float* part = (LAS float*)lds;
    LAS float* ssqp = part + 8 * 16 * 32;
    LAS float* rs = ssqp + 128;
    LAS float* W1t = (LAS float*)(lds + 32768);
    for (int i = tid; i < 4 * D; i += NTHR) { const int c = i >> 11, k = i & (D - 1); W1t[i] = g[k] * wer[k * 16 + 12 + c]; }
    float Bw[16][4];
    { const float* s0 = fr < 4 ? wgr + fr : wer + (fr - 4); const int st0 = fr < 4 ? 4 : 16;
#pragma unroll
      for (int jj = 0; jj < 16; ++jj)
#pragma unroll
        for (int e = 0; e < 4; ++e) { const int k = 256 * w + 16 * jj + 4 * fq + e; Bw[jj][e] = g[k] * s0[k * st0]; } }
    const float m1 = fr < 4 ? 1.f : 0.f;
    const volatile LAS f32x4* w1p = (const volatile LAS f32x4*)(W1t + (fr & 3) * D + 256 * w + 4 * fq);
    __syncthreads();
    for (int t0 = blockIdx.x * 16; t0 < NTOK; t0 += gridDim.x * 16) {
        const float* xr = x1 + (size_t)(t0 + fr) * D + 256 * w + 4 * fq;
        f32x4 acc0 = (f32x4){0.f, 0.f, 0.f, 0.f}, acc1 = (f32x4){0.f, 0.f, 0.f, 0.f}; float sq = 0.f;
#pragma unroll
        for (int hf = 0; hf < 2; ++hf) {
            f32x4 a[8];
#pragma unroll
            for (int jj = 0; jj < 8; ++jj) a[jj] = *(const f32x4*)(xr + 16 * (8 * hf + jj));
#pragma unroll
            for (int jj = 0; jj < 8; ++jj) { f32x4 b1 = w1p[4 * (8 * hf + jj)]; b1 = b1 * m1;
#pragma unroll
                for (int e = 0; e < 4; ++e) { const float av = a[jj][e]; sq += av * av;
                    acc0 = __builtin_amdgcn_mfma_f32_16x16x4f32(av, Bw[8 * hf + jj][e], acc0, 0, 0, 0);
                    acc1 = __builtin_amdgcn_mfma_f32_16x16x4f32(av, b1[e], acc1, 0, 0, 0); } }
        }
        sq += __shfl_xor(sq, 16); sq += __shfl_xor(sq, 32);
#pragma unroll
        for (int r = 0; r < 4; ++r) { part[(w * 16 + 4 * fq + r) * 32 + fr] = acc0[r]; part[(w * 16 + 4 * fq + r) * 32 + 16 + fr] = acc1[r]; }
        if (fq == 0) ssqp[w * 16 + fr] = sq;
        __syncthreads();
        if (tid < 16) {
            float ss = 0.f;
#pragma unroll
            for (int q = 0; q < 8; ++q) ss += ssqp[q * 16 + tid];
            const float rstd = 1.0f / sqrtf(ss * (1.0f / D) + EPS); rs[tid] = rstd;
            float lg[20];
#pragma unroll
            for (int n = 0; n < 20; ++n) { float t = 0.f;
#pragma unroll
                for (int q = 0; q < 8; ++q) t += part[(q * 16 + tid) * 32 + n];
                lg[n] = t * rstd; }
            float gl[4]; int gi = 0; float mx = -3.0e38f;
#pragma unroll
            for (int j = 0; j < 4; ++j) { gl[j] = lg[j] + bgr[j]; if (gl[j] > mx) { mx = gl[j]; gi = j; } }
            float se = 0.f;
#pragma unroll
            for (int j = 0; j < 4; ++j) se += __expf(gl[j] - mx);
            const float pg = 1.0f / se;
            float el[4];
#pragma unroll
            for (int j = 0; j < 4; ++j) { float t = 0.f;
#pragma unroll
                for (int q = 0; q < 4; ++q) t = (gi == q) ? lg[4 + q * 4 + j] + ber[q * 4 + j] : t;
                el[j] = t; }
            int i0 = 0; float v0 = el[0];
#pragma unroll
            for (int j = 1; j < 4; ++j) if (el[j] > v0) { v0 = el[j]; i0 = j; }
            int i1 = -1; float v1 = -3.0e38f;
#pragma unroll
            for (int j = 0; j < 4; ++j) if (j != i0 && el[j] > v1) { v1 = el[j]; i1 = j; }
            const float e1 = __expf(v1 - v0), inv = 1.0f / (1.0f + e1);
            const int ea = gi * 4 + i0, eb = gi * 4 + i1, row = t0 + tid;
            tok_e[2 * row] = ea; tok_e[2 * row + 1] = eb; tok_w[2 * row] = pg * inv; tok_w[2 * row + 1] = pg * e1 * inv;
            atomicAdd(&cnt[ea], 1); atomicAdd(&cnt[eb], 1);
        }
        __syncthreads();
        for (int i = tid; i < 16 * 512; i += NTHR) { const int row = i >> 9, c4 = (i & 511) * 4; const float r = rs[row];
            const f32x4 xv = *(const f32x4*)(x1 + (size_t)(t0 + row) * D + c4), gv = *(const f32x4*)(g + c4);
            *(u32x2*)(HB + (size_t)(t0 + row) * D + c4) = (u32x2){pk2(xv[0] * r * gv[0], xv[1] * r * gv[1]), pk2(xv[2] * r * gv[2], xv[3] * r * gv[3])}; }
        __syncthreads();
    }
}

struct TI { int tid, lane, wid, gtid, gwave; };
__device__ __forceinline__ TI ti() { int t = threadIdx.x; asm volatile("" : "+v"(t)); TI r; r.tid = t; r.lane = t & 63; r.wid = t >> 6; r.gtid = blockIdx.x * NTHR + t; r.gwave = blockIdx.x * NWAVE + (t >> 6); return r; }

__global__ __launch_bounds__(NTHR, 2) void mega(Params p) {
    extern __shared__ __attribute__((aligned(16))) unsigned char lds_raw[];
    LAS unsigned char* lds = (LAS unsigned char*)lds_raw;
    lds_tile_t As = (lds_tile_t)(lds); lds_tile_t Bs = (lds_tile_t)(lds + 256 * 40 * 2);
    cg::grid_group grid = cg::this_grid();
    { volatile LAS unsigned* stw = (volatile LAS unsigned*)(lds + LDS_BYTES - 16); if (threadIdx.x < 4) stw[threadIdx.x] = 0u; }
    __syncthreads();
    const XcdBarrier xbar = xcd_barrier_post((unsigned*)(p.ws + BAR_OFF), (volatile LAS unsigned*)(lds + LDS_BYTES - 16));
    if (p.ws == nullptr) grid.sync();
#define GSYNC() xcd_barrier(xbar)
    const int gthreads = gridDim.x * NTHR, gwaves = gridDim.x * NWAVE;
    char* ws = p.ws; float* out = p.out;
    bf16_t* HB = (bf16_t*)(ws + 0 * MiB);
    bf16_t* WTIN = (bf16_t*)(ws + 64 * MiB);
    bf16_t* WTOUT = (bf16_t*)(ws + 72 * MiB);
    char* sm = ws + 80 * MiB;
    bf16_t* MT = (bf16_t*)(ws + 84 * MiB);
    bf16_t* WGU = (bf16_t*)(ws + 96 * MiB);
    bf16_t* WDN = (bf16_t*)(ws + 160 * MiB);
    bf16_t* UB = (bf16_t*)(ws + 192 * MiB);
    bf16_t* B1 = (bf16_t*)(ws + 256 * MiB);
    bf16_t* YA = (bf16_t*)(ws + 320 * MiB);
    bf16_t* MIXB = (bf16_t*)(ws + 384 * MiB);
    bf16_t* YD = (bf16_t*)(ws + 192 * MiB);
    bf16_t* ACT = (bf16_t*)(ws + 320 * MiB);
    float* ct = (float*)(sm); float* st = (float*)(sm + 16384);
    int* cnt = (int*)(sm + 32768); int* off = cnt + 64; int* cur = cnt + 128;
    int* tok_e = (int*)(sm + 65536); float* tok_w = (float*)(sm + 65536 + 131072);
    int* list = (int*)(sm + 65536 + 2 * 131072); int* tpos = (int*)(sm + 65536 + 3 * 131072); float* pw = (float*)(sm + 65536 + 4 * 131072);
    bf16_t* TAB1 = (bf16_t*)(sm + 1 * MiB); bf16_t* TAB2 = (bf16_t*)(sm + 1 * MiB + 32768);
    LAS unsigned* rowtab = (LAS unsigned*)(lds + 131072);
    f32x4 v[8];

    { const TI T = ti(); const int tid = T.tid, lane = T.lane, wid = T.wid, gtid = T.gtid, gwave = T.gwave; (void)tid; (void)lane; (void)wid; (void)gtid; (void)gwave;
    for (int i = gtid; i < 4096; i += gthreads) { ct[i] = cospif((float)i / 2048.0f); st[i] = sinpif((float)i / 2048.0f); }
    if (gtid < 192) cnt[gtid] = 0;
    dft_make_tables(TAB1, TAB2, gtid, gthreads);
    { LAS float* c256 = (LAS float*)(lds + 139264); if (tid < 256) { c256[tid] = cospif((float)tid / 128.0f); c256[256 + tid] = sinpif((float)tid / 128.0f); }
      __syncthreads();
      for (int i = gtid; i < 4 * 512 * 256; i += gthreads) { const int e = i & 255, kk = (i >> 8) & 511, h = i >> 17, j = kk & 255; const LAS float* tb = c256 + (kk < 256 ? 0 : 256);
          float a = 0.f;
          for (int m = 0; m < 256; ++m) a += tb[(j * m) & 255] * p.w_fourier[((size_t)h * 256 + m) * 256 + e];
          MT[((size_t)h * 256 + e) * 512 + kk] = (bf16_t)f2bf(a * (1.0f / 1024.0f)); }
      __syncthreads(); }
    { LdA a{p.w_in, D, 0, GD}; LdB b{p.w_pool, GD, (long)GD * GD, 0}; EpEl<StoreT> e{{WTIN, p.pool_scale}};
      sgemm_phase(a, b, e, GD, GD / 128, D / 256, 4, As, Bs); }
    { LAS float* scr = (LAS float*)(lds + wid * 16384);
      constexpr int I_WI = (D / 64) * (FW / 32), I_W = (D / 64) * (D / 32), I_E = 512, NIT = I_WI + I_W + NE * 3 * I_E;
      for (int it = gwave; it < NIT; it += gwaves) {
          if (it < I_WI) { const int n0 = 1024 + 32 * (it % 32); transpose_item(p.w_in, D, 64 * (it / 32), n0, WTIN + (size_t)n0 * D, D, scr, lane); continue; }
          if (it < I_WI + I_W) { const int r = it - I_WI; transpose_item(p.w_out, D, 64 * (r / 64), 32 * (r % 64), WTOUT + (size_t)(32 * (r % 64)) * D, D, scr, lane); continue; }
          const int r = it - I_WI - I_W, e = r / (3 * I_E), q = (r % (3 * I_E)) / I_E, j = r % I_E;
          if (q < 2) { const int k0 = 64 * (j / 16), n0 = 32 * (j % 16); const float* W = (q == 0 ? p.w_gate : p.w_up) + (size_t)e * D * FF;
              transpose_item(W, FF, k0, n0, WGU + ((size_t)e * 1024 + (n0 >> 7) * 256 + (n0 & 127) + q * 128) * D, D, scr, lane); }
          else { const int k0 = 64 * (j / 64), n0 = 32 * (j % 64);
              transpose_item(p.w_down + (size_t)e * FF * D, D, k0, n0, WDN + ((size_t)e * D + n0) * FF, FF, scr, lane); }
      } }
    for (int row = gwave; row < NTOK; row += gwaves) rms_row(p.x, p.g_mix, nullptr, HB, row, lane, nullptr, nullptr, v);
    }
    GSYNC();
    { const TI T = ti(); const int tid = T.tid, lane = T.lane, wid = T.wid, gtid = T.gtid, gwave = T.gwave; (void)tid; (void)lane; (void)wid; (void)gtid; (void)gwave;
    { PolBf16 S; S.init(NTOK / 256, D / 256, gridDim.x, blockIdx.x); S.K = D; S.A = HB; S.Bt = WTIN; S.C = UB; S.lda_b = D * 2; S.acol_b = 0; S.ldc = D; S.ccol0 = 0;
      pg8::gemm_phase(lds, S); }
    }
    GSYNC();
    { const TI T = ti(); const int tid = T.tid, lane = T.lane, wid = T.wid, gtid = T.gtid, gwave = T.gwave; (void)tid; (void)lane; (void)wid; (void)gtid; (void)gwave;
    dft_pass<1>(lds, UB, B1, TAB1, ct, st);
    pool_pass(UB, MIXB, gtid, gthreads);
    }
    GSYNC();
    { const TI T = ti(); const int tid = T.tid, lane = T.lane, wid = T.wid, gtid = T.gtid, gwave = T.gwave; (void)tid; (void)lane; (void)wid; (void)gtid; (void)gwave;
    dft_pass<2>(lds, B1, YA, TAB2, ct, st);
    }
    GSYNC();
    { const TI T = ti(); const int tid = T.tid, lane = T.lane, wid = T.wid, gtid = T.gtid, gwave = T.gwave; (void)tid; (void)lane; (void)wid; (void)gtid; (void)gwave;
    { PolBf16 S; S.init(NTOK / 256, 4, gridDim.x, blockIdx.x); S.K = 512; S.A = YA; S.Bt = MT; S.C = MIXB; S.lda_b = D * 2; S.acol_b = 1024; S.ldc = D; S.ccol0 = 1024;
      pg8::gemm_phase(lds, S); }
    }
    GSYNC();
    { const TI T = ti(); const int tid = T.tid, lane = T.lane, wid = T.wid, gtid = T.gtid, gwave = T.gwave; (void)tid; (void)lane; (void)wid; (void)gtid; (void)gwave;
    { PolGemmOut S; S.init(NTOK / 256, D / 256, gridDim.x, blockIdx.x); S.K = D; S.A = MIXB; S.Bt = WTOUT; S.C = out; S.X = p.x;
      pg8::gemm_phase(lds, S); }
    }
    GSYNC();
    { const TI T = ti(); const int tid = T.tid, lane = T.lane, wid = T.wid, gtid = T.gtid, gwave = T.gwave; (void)tid; (void)lane; (void)wid; (void)gtid; (void)gwave;
    router_phase(lds, out, p.g_ffn, p.wgr, p.bgr, p.wer, p.ber, HB, tok_e, tok_w, cnt);
    }
    GSYNC();
    { const TI T = ti(); const int tid = T.tid, lane = T.lane, wid = T.wid, gtid = T.gtid, gwave = T.gwave; (void)tid; (void)lane; (void)wid; (void)gtid; (void)gwave;
    { int offl[NE]; int s = 0;
#pragma unroll
      for (int e = 0; e < NE; ++e) { offl[e] = s; s += cnt[e]; }
      if (gtid < NE) { int o = 0; for (int e = 0; e < gtid; ++e) o += cnt[e]; off[gtid] = o; }
      for (int i = gtid; i < 2 * NTOK; i += gthreads) {
          const int e = tok_e[i]; int o = 0;
#pragma unroll
          for (int q = 0; q < NE; ++q) o = (q == e) ? offl[q] : o;
          const int pos = o + atomicAdd(&cur[e], 1);
          list[pos] = i >> 1; tpos[i] = pos; pw[pos] = tok_w[i]; } }
    }
    GSYNC();
    { const TI T = ti(); const int tid = T.tid, lane = T.lane, wid = T.wid, gtid = T.gtid, gwave = T.gwave; (void)tid; (void)lane; (void)wid; (void)gtid; (void)gwave;
    { PolMoeUp S; S.init(4, gridDim.x, blockIdx.x, cnt); S.K = D; S.A = HB; S.Bt = WGU; S.ACT = ACT; S.pw = pw; S.rowtab = rowtab;
      pg8::Unit u;
      for (int i = 0; i < 8; ++i) { if (!S.next(i, u)) break;
          if (tid < 256) { const int rr = tid < u.nrows ? tid : u.nrows - 1; rowtab[i * 256 + tid] = (unsigned)list[u.rowbase + rr] * (unsigned)(D * 2); } }
      __syncthreads();
      pg8::gemm_phase(lds, S); }
    }
    GSYNC();
    { const TI T = ti(); const int tid = T.tid, lane = T.lane, wid = T.wid, gtid = T.gtid, gwave = T.gwave; (void)tid; (void)lane; (void)wid; (void)gtid; (void)gwave;
    { PolMoeDown S; S.init(8, gridDim.x, blockIdx.x, cnt); S.K = FF; S.A = ACT; S.Bt = WDN; S.YD = YD;
      pg8::gemm_phase(lds, S); }
    }
    GSYNC();
    { const TI T = ti(); const int tid = T.tid, lane = T.lane, wid = T.wid, gtid = T.gtid, gwave = T.gwave; (void)tid; (void)lane; (void)wid; (void)gtid; (void)gwave;
    for (int row = gwave; row < NTOK; row += gwaves) rms_row(out, p.g_final, out, nullptr, row, lane, YD, tpos, v);
    }
}

extern "C" void kernel_launch(void* const* d_in, const int* in_sizes, int n_in, void* d_out, int out_size, void* d_ws, size_t ws_size, hipStream_t stream) {
    static int grid_blocks = 0;
    if (!grid_blocks) {
        int dev = 0, cus = 0, per_cu = 0;
        (void)hipGetDevice(&dev);
        (void)hipDeviceGetAttribute(&cus, hipDeviceAttributeMultiprocessorCount, dev);
        (void)hipFuncSetAttribute((const void*)mega, hipFuncAttributeMaxDynamicSharedMemorySize, LDS_BYTES);
        (void)hipOccupancyMaxActiveBlocksPerMultiprocessor(&per_cu, mega, NTHR, LDS_BYTES);
        if (per_cu > 1) per_cu = 1;
        grid_blocks = cus * per_cu;
    }
    if (ws_size < 512 * MiB || grid_blocks <= 0) { fprintf(stderr, "workspace too small or no occupancy\n"); return; }
    (void)hipMemsetAsync((char*)d_ws + BAR_OFF, 0, 16384, stream);
    Params p{};
    p.x = (const float*)d_in[0]; p.g_mix = (const float*)d_in[1]; p.w_in = (const float*)d_in[2]; p.w_pool = (const float*)d_in[3];
    p.pool_scale = (const float*)d_in[4]; p.w_fourier = (const float*)d_in[5]; p.w_out = (const float*)d_in[6]; p.g_ffn = (const float*)d_in[7];
    p.wgr = (const float*)d_in[8]; p.bgr = (const float*)d_in[9]; p.wer = (const float*)d_in[10]; p.ber = (const float*)d_in[11];
    p.w_gate = (const float*)d_in[12]; p.w_up = (const float*)d_in[13]; p.w_down = (const float*)d_in[14]; p.g_final = (const float*)d_in[15];
    p.out = (float*)d_out; p.ws = (char*)d_ws;
    void* args[] = {&p};
    hipError_t e = hipLaunchCooperativeKernel((void*)mega, dim3(grid_blocks), dim3(NTHR), args, LDS_BYTES, stream);
    if (e != hipSuccess) fprintf(stderr, "cooperative launch failed: %s (grid %d)\n", hipGetErrorString(e), grid_blocks);
}
```

```cpp
#include <hip/hip_runtime.h>
#include <stdint.h>
#include <stdio.h>
#include <hip/hip_cooperative_groups.h>
namespace cg = cooperative_groups;

typedef unsigned short bf16_t;
typedef short bf16x8 __attribute__((ext_vector_type(8)));
typedef float f32x4 __attribute__((ext_vector_type(4)));
typedef unsigned u32x4 __attribute__((ext_vector_type(4)));
typedef unsigned u32x2 __attribute__((ext_vector_type(2)));
#define LAS __attribute__((address_space(3)))

constexpr int D = 2048, BATCH = 4, SEQ = 4096, NTOK = BATCH * SEQ;
constexpr int PW = 1024, FW = 1024, GD = 256, NE = 16, FF = 512;
constexpr float EPS = 1e-6f;
constexpr int NTHR = 512, NWAVE = 8;
constexpr int LDS_BYTES = 147456;
#define PROBE 0
#define PROBE_A 0
#define PROBE_B 1
#define PROBE_C 2
constexpr size_t MiB = 1u << 20;
constexpr size_t BAR_OFF = 82 * MiB;

__device__ __forceinline__ unsigned f2bf(float f) { unsigned u = __float_as_uint(f); return (u + 0x7fffu + ((u >> 16) & 1u)) >> 16; }
__device__ __forceinline__ unsigned pk2(float lo, float hi) { return f2bf(lo) | (f2bf(hi) << 16); }
__device__ __forceinline__ float bf2f(unsigned short b) { return __uint_as_float(((unsigned)b) << 16); }
__device__ __forceinline__ float wave_sum(float v) {
#pragma unroll
    for (int o = 1; o < 64; o <<= 1) v += __shfl_xor(v, o);
    return v;
}

namespace pg8 {
constexpr int BM = 256, BK = 64, HALF = 128, HTB = HALF * BK * 2, STAGE_BYTES = 8 * HTB, NXCD = 8, WGM = 8;
__host__ __device__ __forceinline__ int lds_byte(int r, int c) { const int st = (r >> 4) * 2 + (c >> 5), rr = r & 15, cc = c & 31, ob = rr * 64 + cc * 2; return st * 1024 + (ob ^ (((ob >> 9) & 1) << 5)); }
__host__ __device__ __forceinline__ void stage_rc(int b, int& R, int& C) { const int st = b / 1024, sb = b % 1024, swz = sb ^ (((sb >> 9) & 1) << 5); R = (st >> 1) * 16 + swz / 64; C = (st & 1) * 32 + (swz % 64) / 2; }

struct Unit { int pm, pn, g, idx, rowbase, nrows; };

struct GridOrder {
    int nM, nN, nwg, G, c;
    __device__ void init(int nM_, int nN_, int G_, int c_) { nM = nM_; nN = nN_; nwg = nM * nN; G = G_; c = c_; }
    __device__ bool next(int i, Unit& u) const {
        const long L = (long)i * G + c; if (L >= nwg) return false;
        int wgid = (int)L; { const int q = nwg / NXCD, r = nwg % NXCD, xcd = wgid % NXCD, off = wgid / NXCD; wgid = (xcd < r ? xcd * (q + 1) : r * (q + 1) + (xcd - r) * q) + off; }
        const int nig = WGM * nN, gid = wgid / nig, fm = gid * WGM, gsz = (nM - fm) < WGM ? (nM - fm) : WGM;
        u.pm = fm + ((wgid % nig) % gsz); u.pn = (wgid % nig) / gsz; u.g = 0; u.idx = i; u.rowbase = 0; u.nrows = 256; return true;
    }
};

template <class P>
__device__ __forceinline__ void gemm_phase(LAS unsigned char* lds, const P& S) {
    int tid_ = threadIdx.x; asm volatile("" : "+v"(tid_));
    const int tid = tid_, wid = __builtin_amdgcn_readfirstlane(tid >> 6), lane = tid & 63, wr = wid >> 2, wc = wid & 3, fr = lane & 15, fq = lane >> 4;
    const int K = S.K, nt = K / BK;
    int Rp[2], Cp[2]; unsigned voffB[2];
#pragma unroll
    for (int i = 0; i < 2; ++i) { stage_rc(tid * 16 + i * 8192, Rp[i], Cp[i]); voffB[i] = (unsigned)(Rp[i] * K + Cp[i]) * 2u; }
    const size_t kstep = (size_t)(BK * 2);
    const size_t hstepB = (size_t)HALF * K * 2;
    const unsigned ldsw = (unsigned)wid * 1024u;
    const int aoff = lds_byte(wr * 64 + fr, fq * 8), boff = lds_byte(wc * 32 + fr, fq * 8);
#define PG8_SA(b, h) (((b) * 2 + (h)) * HTB)
#define PG8_SB(b, h) ((4 + (b) * 2 + (h)) * HTB)
#define PG8_STAGE(bufoff, gbase, voff) do { _Pragma("unroll") for (int _i = 0; _i < 2; ++_i) \
        __builtin_amdgcn_global_load_lds((const unsigned*)((const char*)(gbase) + (voff)[_i]), (LAS unsigned*)(lds + (bufoff) + ldsw + _i * 8192), 16, 0, 0); } while (0)
#define PG8_LDA(dst, b, h) do { _Pragma("unroll") for (int m = 0; m < 4; ++m) _Pragma("unroll") for (int k = 0; k < 2; ++k) dst[m][k] = *(const LAS bf16x8*)(lds + PG8_SA(b, h) + aoff + m * 2048 + k * 1024); } while (0)
#define PG8_LDB(dst, b, h) do { _Pragma("unroll") for (int n = 0; n < 2; ++n) _Pragma("unroll") for (int k = 0; k < 2; ++k) dst[n][k] = *(const LAS bf16x8*)(lds + PG8_SB(b, h) + boff + n * 2048 + k * 1024); } while (0)
#define PG8_MMA(ai, bj, At, Bt) do { __builtin_amdgcn_s_setprio(1); _Pragma("unroll") for (int m = 0; m < 4; ++m) _Pragma("unroll") for (int n = 0; n < 2; ++n) _Pragma("unroll") for (int k = 0; k < 2; ++k) \
        acc[ai][bj][m][n] = __builtin_amdgcn_mfma_f32_16x16x32_bf16(Bt[n][k], At[m][k], acc[ai][bj][m][n], 0, 0, 0); __builtin_amdgcn_s_setprio(0); } while (0)
#define PG8_WAIT_V(n) asm volatile("s_waitcnt vmcnt(" #n ")" ::: "memory")
#define PG8_WAIT_L(n) asm volatile("s_waitcnt lgkmcnt(" #n ")" ::: "memory")
#define PG8_BAR __builtin_amdgcn_s_barrier()
#define PG8_SCHED __builtin_amdgcn_sched_barrier(0)
    Unit cur, nxt; int ui = 0;
    if (!S.next(0, cur)) return;
    f32x4 acc[2][2][4][2];
#pragma unroll
    for (int a = 0; a < 2; ++a)
#pragma unroll
        for (int b = 0; b < 2; ++b)
#pragma unroll
            for (int m = 0; m < 4; ++m)
#pragma unroll
                for (int n = 0; n < 2; ++n) acc[a][b][m][n] = (f32x4){0.f, 0.f, 0.f, 0.f};
    bf16x8 At[4][2], B0[2][2], B1[2][2];
    const char* const aB = S.a_base();
    unsigned oc0[2], oc1[2];
#pragma unroll
    for (int i = 0; i < 2; ++i) { oc0[i] = S.a_row_off(cur, Rp[i]) + (unsigned)Cp[i] * 2u; oc1[i] = S.a_row_off(cur, HALF + Rp[i]) + (unsigned)Cp[i] * 2u; }
    const char* cB = S.b_tile(cur);
    PG8_STAGE(PG8_SB(0, 0), cB, voffB); PG8_STAGE(PG8_SB(0, 1), cB + hstepB, voffB); PG8_STAGE(PG8_SA(0, 0), aB, oc0); PG8_STAGE(PG8_SA(0, 1), aB, oc1);
    if (wr == 1) PG8_BAR;
    PG8_WAIT_V(2); PG8_BAR;
    PG8_STAGE(PG8_SB(1, 0), cB + kstep, voffB); PG8_STAGE(PG8_SA(1, 0), aB + kstep, oc0); PG8_STAGE(PG8_SB(1, 1), cB + hstepB + kstep, voffB);
    PG8_WAIT_V(6); PG8_BAR;
    for (;;) {
        const bool has_next = S.next(ui + 1, nxt);
        unsigned on0[2], on1[2];
#pragma unroll
        for (int i = 0; i < 2; ++i) { on0[i] = has_next ? S.a_row_off(nxt, Rp[i]) + (unsigned)Cp[i] * 2u : oc0[i]; on1[i] = has_next ? S.a_row_off(nxt, HALF + Rp[i]) + (unsigned)Cp[i] * 2u : oc1[i]; }
        const char* nB = has_next ? S.b_tile(nxt) : cB;
        for (int t = 0; t < nt; t += 2) {
            const bool last = (t == nt - 2);
            const char* a1 = aB + (size_t)(t + 1) * kstep;
            const char* a2 = last ? aB : aB + (size_t)(t + 2) * kstep; const char* b2 = last ? nB : cB + (size_t)(t + 2) * kstep;
            const char* a3 = a2 + kstep; const char* b3 = b2 + kstep;
            unsigned o20[2], o21[2];
#pragma unroll
            for (int i = 0; i < 2; ++i) { o20[i] = last ? on0[i] : oc0[i]; o21[i] = last ? on1[i] : oc1[i]; }
            PG8_LDB(B0, 0, 0); PG8_LDB(B1, 0, 1); PG8_SCHED; PG8_LDA(At, 0, 0); PG8_STAGE(PG8_SA(1, 1), a1, oc1);
            PG8_WAIT_V(8); PG8_WAIT_L(0); PG8_BAR; PG8_MMA(0, 0, At, B0); PG8_MMA(0, 1, At, B1); PG8_BAR; PG8_SCHED;
            PG8_LDA(At, 0, 1); PG8_STAGE(PG8_SB(0, 0), b2, voffB); PG8_STAGE(PG8_SB(0, 1), b2 + hstepB, voffB); PG8_STAGE(PG8_SA(0, 0), a2, o20);
            PG8_WAIT_V(8); PG8_WAIT_L(0); PG8_BAR; PG8_MMA(1, 0, At, B0); PG8_MMA(1, 1, At, B1); PG8_BAR; PG8_SCHED;
            PG8_LDB(B0, 1, 0); PG8_LDB(B1, 1, 1); PG8_SCHED; PG8_LDA(At, 1, 0); PG8_STAGE(PG8_SA(0, 1), a2, o21);
            PG8_WAIT_V(8); PG8_WAIT_L(0); PG8_BAR; PG8_MMA(0, 0, At, B0); PG8_MMA(0, 1, At, B1); PG8_BAR; PG8_SCHED;
            PG8_LDA(At, 1, 1); PG8_STAGE(PG8_SB(1, 0), b3, voffB); PG8_STAGE(PG8_SB(1, 1), b3 + hstepB, voffB); PG8_STAGE(PG8_SA(1, 0), a3, o20);
            PG8_WAIT_V(8); PG8_WAIT_L(0); PG8_BAR; PG8_MMA(1, 0, At, B0); PG8_MMA(1, 1, At, B1); PG8_BAR; PG8_SCHED;
        }
        if (wr == 0) PG8_BAR;
        S.epi(acc, cur, wr, wc, fr, fq);
        if (!has_next) break;
#pragma unroll
        for (int a = 0; a < 2; ++a)
#pragma unroll
            for (int b = 0; b < 2; ++b)
#pragma unroll
                for (int m = 0; m < 4; ++m)
#pragma unroll
                    for (int n = 0; n < 2; ++n) acc[a][b][m][n] = (f32x4){0.f, 0.f, 0.f, 0.f};
        cur = nxt; cB = nB; ++ui;
#pragma unroll
        for (int i = 0; i < 2; ++i) { oc0[i] = on0[i]; oc1[i] = on1[i]; }
        if (wr == 1) PG8_BAR;
    }
    PG8_WAIT_V(0);
    PG8_BAR;
#undef PG8_SA
#undef PG8_SB
#undef PG8_STAGE
#undef PG8_LDA
#undef PG8_LDB
#undef PG8_MMA
#undef PG8_WAIT_V
#undef PG8_WAIT_L
#undef PG8_BAR
#undef PG8_SCHED
}
}

struct PolBf16 : pg8::GridOrder {
    int K; const bf16_t* A; const bf16_t* Bt; bf16_t* C; int lda_b, acol_b, ldc, ccol0;
    __device__ const char* a_base() const { return (const char*)A; }
    __device__ unsigned a_row_off(const pg8::Unit& u, int r) const { return (unsigned)(u.pm * 256 + r) * (unsigned)lda_b + (unsigned)(u.pn * acol_b); }
    __device__ const char* b_tile(const pg8::Unit& u) const { return (const char*)Bt + (size_t)u.pn * 256 * K * 2; }
    __device__ void epi(const f32x4 (&acc)[2][2][4][2], const pg8::Unit& u, int wr, int wc, int fr, int fq) const {
        const int row0 = u.pm * 256 + wr * 64 + fr, col0 = ccol0 + u.pn * 256 + wc * 32 + 4 * fq;
#pragma unroll
        for (int ai = 0; ai < 2; ++ai)
#pragma unroll
            for (int m = 0; m < 4; ++m) { bf16_t* rowp = C + (size_t)(row0 + ai * 128 + m * 16) * ldc + col0;
#pragma unroll
                for (int bj = 0; bj < 2; ++bj)
#pragma unroll
                    for (int n = 0; n < 2; ++n) { const f32x4 a = acc[ai][bj][m][n]; *(u32x2*)(rowp + bj * 128 + n * 16) = (u32x2){pk2(a[0], a[1]), pk2(a[2], a[3])}; } }
    }
};
struct PolGemmOut : pg8::GridOrder {
    int K; const bf16_t* A; const bf16_t* Bt; float* C; const float* X;
    __device__ const char* a_base() const { return (const char*)A; }
    __device__ unsigned a_row_off(const pg8::Unit& u, int r) const { return (unsigned)(u.pm * 256 + r) * (unsigned)(K * 2); }
    __device__ const char* b_tile(const pg8::Unit& u) const { return (const char*)Bt + (size_t)u.pn * 256 * K * 2; }
    __device__ void epi(const f32x4 (&acc)[2][2][4][2], const pg8::Unit& u, int wr, int wc, int fr, int fq) const {
        const int row0 = u.pm * 256 + wr * 64 + fr, col0 = u.pn * 256 + wc * 32 + 4 * fq;
#pragma unroll
        for (int ai = 0; ai < 2; ++ai) {
            f32x4 xv[4][2][2];
#pragma unroll
            for (int m = 0; m < 4; ++m)
#pragma unroll
                for (int bj = 0; bj < 2; ++bj)
#pragma unroll
                    for (int n = 0; n < 2; ++n) xv[m][bj][n] = *(const f32x4*)(X + (size_t)(row0 + ai * 128 + m * 16) * D + col0 + bj * 128 + n * 16);
#pragma unroll
            for (int m = 0; m < 4; ++m)
#pragma unroll
                for (int bj = 0; bj < 2; ++bj)
#pragma unroll
                    for (int n = 0; n < 2; ++n) *(f32x4*)(C + (size_t)(row0 + ai * 128 + m * 16) * D + col0 + bj * 128 + n * 16) = acc[ai][bj][m][n] + xv[m][bj][n];
        }
    }
};

struct MoeOrder {
    int nN, rtx, xcd, slot, G; const int* cnt;
    __device__ void init(int nN_, int G_, int c_, const int* cnt_) { nN = nN_; G = G_; xcd = c_ & 7; slot = c_ >> 3; rtx = (G_ >> 3) / nN_; cnt = cnt_; }
    __device__ bool next(int i, pg8::Unit& u) const {
        const int rt = (i * 8 + xcd) * rtx + slot % rtx; u.pn = slot / rtx; u.idx = i;
        int acc_t = 0, acc_r = 0; bool found = false; u.pm = 0; u.g = 0; u.rowbase = 0; u.nrows = 0;
        for (int e = 0; e < NE; ++e) { const int c = cnt[e], nt_e = (c + 255) >> 8;
            if (!found && rt < acc_t + nt_e) { found = true; u.g = e; u.pm = rt - acc_t; u.rowbase = acc_r + u.pm * 256; const int rem = c - u.pm * 256; u.nrows = rem < 256 ? rem : 256; }
            acc_t += nt_e; acc_r += c; }
        return found;
    }
};
__device__ __forceinline__ float silu_f(float g) { return g / (1.f + __expf(-g)); }
struct PolMoeUp : MoeOrder {
    int K; const bf16_t* A; const bf16_t* Bt; bf16_t* ACT; const float* pw; const LAS unsigned* rowtab;
    __device__ const char* a_base() const { return (const char*)A; }
    __device__ unsigned a_row_off(const pg8::Unit& u, int r) const { return rowtab[u.idx * 256 + r]; }
    __device__ const char* b_tile(const pg8::Unit& u) const { return (const char*)Bt + ((size_t)u.g * 1024 + (size_t)u.pn * 256) * K * 2; }
    __device__ void epi(const f32x4 (&acc)[2][2][4][2], const pg8::Unit& u, int wr, int wc, int fr, int fq) const {
#pragma unroll
        for (int ai = 0; ai < 2; ++ai)
#pragma unroll
            for (int m = 0; m < 4; ++m) { const int r = ai * 128 + wr * 64 + m * 16 + fr; if (r >= u.nrows) continue;
                const size_t pos = (size_t)u.rowbase + r; const float w = pw[pos];
#pragma unroll
                for (int n = 0; n < 2; ++n) { const f32x4 g = acc[ai][0][m][n], v = acc[ai][1][m][n];
                    const int f = u.pn * 128 + wc * 32 + n * 16 + fq * 4;
                    *(u32x2*)(ACT + pos * FF + f) = (u32x2){pk2(silu_f(g[0]) * v[0] * w, silu_f(g[1]) * v[1] * w), pk2(silu_f(g[2]) * v[2] * w, silu_f(g[3]) * v[3] * w)}; } }
    }
};
struct PolMoeDown : MoeOrder {
    int K; const bf16_t* A; const bf16_t* Bt; bf16_t* YD;
    __device__ const char* a_base() const { return (const char*)A; }
    __device__ unsigned a_row_off(const pg8::Unit& u, int r) const { const int rr = r < u.nrows ? r : u.nrows - 1; return (unsigned)(u.rowbase + rr) * (unsigned)(K * 2); }
    __device__ const char* b_tile(const pg8::Unit& u) const { return (const char*)Bt + ((size_t)u.g * 2048 + (size_t)u.pn * 256) * K * 2; }
    __device__ void epi(const f32x4 (&acc)[2][2][4][2], const pg8::Unit& u, int wr, int wc, int fr, int fq) const {
#pragma unroll
        for (int ai = 0; ai < 2; ++ai)
#pragma unroll
            for (int m = 0; m < 4; ++m) { const int r = ai * 128 + wr * 64 + m * 16 + fr; if (r >= u.nrows) continue;
                bf16_t* rowp = YD + ((size_t)u.rowbase + r) * D + u.pn * 256 + wc * 32 + fq * 4;
#pragma unroll
                for (int bj = 0; bj < 2; ++bj)
#pragma unroll
                    for (int n = 0; n < 2; ++n) { const f32x4 a = acc[ai][bj][m][n]; *(u32x2*)(rowp + bj * 128 + n * 16) = (u32x2){pk2(a[0], a[1]), pk2(a[2], a[3])}; } }
    }
};

typedef bf16_t LAS (*lds_tile_t)[40];
template <class AL, class BL, class EP>
__device__ __forceinline__ void gemm_tile(const AL& al, const BL& bl, const EP& ep, const int K, const int bxi, const int byi, const int bz, lds_tile_t As, lds_tile_t Bs) {
    const int tid = threadIdx.x, wid = tid >> 6, lane = tid & 63;
    const int bm = byi * 256, bn = bxi * 128;
    const int wr = wid >> 1, wc = wid & 1;
    f32x4 acc[4][4];
#pragma unroll
    for (int m = 0; m < 4; ++m)
#pragma unroll
        for (int n = 0; n < 4; ++n) acc[m][n] = (f32x4){0.f, 0.f, 0.f, 0.f};
    for (int k0 = 0; k0 < K; k0 += 32) {
#pragma unroll
        for (int i = 0; i < 4; ++i) {
            const int row = (tid >> 3) + 64 * i, kk = (tid & 7) * 4;
            const float4 v = al.load4(bz, bm + row, k0 + kk);
            *(LAS u32x2*)&As[row][kk] = (u32x2){pk2(v.x, v.y), pk2(v.z, v.w)};
        }
#pragma unroll
        for (int i = 0; i < 2; ++i) {
            const int k = (tid >> 5) + 16 * i, n = (tid & 31) * 4;
            const float4 v = bl.load4(bz, k0 + k, bn + n, n);
            Bs[n + 0][k] = (bf16_t)f2bf(v.x); Bs[n + 1][k] = (bf16_t)f2bf(v.y); Bs[n + 2][k] = (bf16_t)f2bf(v.z); Bs[n + 3][k] = (bf16_t)f2bf(v.w);
        }
        __syncthreads();
        bf16x8 a[4], b[4];
#pragma unroll
        for (int m = 0; m < 4; ++m) a[m] = *(const LAS bf16x8*)&As[wr * 64 + m * 16 + (lane & 15)][(lane >> 4) * 8];
#pragma unroll
        for (int n = 0; n < 4; ++n) b[n] = *(const LAS bf16x8*)&Bs[wc * 64 + n * 16 + (lane & 15)][(lane >> 4) * 8];
#pragma unroll
        for (int m = 0; m < 4; ++m)
#pragma unroll
            for (int n = 0; n < 4; ++n) acc[m][n] = __builtin_amdgcn_mfma_f32_16x16x32_bf16(a[m], b[n], acc[m][n], 0, 0, 0);
        __syncthreads();
    }
    ep(bz, bm, bn, wr, wc, lane, acc);
}
template <class AL, class BL, class EP>
__device__ __forceinline__ void sgemm_phase(const AL& al, const BL& bl, const EP& ep, int K, int nx, int ny, int nz, lds_tile_t As, lds_tile_t Bs) {
    const int total = nx * ny * nz;
    for (int t = blockIdx.x; t < total; t += gridDim.x) {
        const int bxi = t % nx, byi = (t / nx) % ny, bz = t / (nx * ny);
        if (!al.active(bz, byi * 256)) continue;
        gemm_tile(al, bl, ep, K, bxi, byi, bz, As, Bs);
    }
}

struct LdA { const float* p; long ld, zs; long coff_z;
    __device__ bool active(int, int) const { return true; }
    __device__ float4 load4(int z, int r, int c) const { return *(const float4*)(p + (long)z * zs + (long)r * ld + (long)z * coff_z + c); } };
struct LdB { const float* p; long ld, zs; long coff_z;
    __device__ float4 load4(int z, int k, int n, int) const { return *(const float4*)(p + (long)z * zs + (long)k * ld + (long)z * coff_z + n); } };
template <class F> struct EpEl { F f;
    __device__ void operator()(int z, int bm, int bn, int wr, int wc, int lane, const f32x4 (&acc)[4][4]) const {
#pragma unroll
        for (int m = 0; m < 4; ++m)
#pragma unroll
            for (int n = 0; n < 4; ++n)
#pragma unroll
                for (int r = 0; r < 4; ++r) f(z, bm + wr * 64 + m * 16 + (lane >> 4) * 4 + r, bn + wc * 64 + n * 16 + (lane & 15), acc[m][n][r]);
    } };
struct StoreF { float* p; long ld, zs; long coff_z; const float* scale;
    __device__ void operator()(int z, int r, int n, float v) const {
        const long o = (long)z * zs + (long)r * ld + (long)z * coff_z + n;
        if (scale) v *= scale[z * coff_z + n];
        p[o] = v; } };
struct StoreB { bf16_t* p; long ld, zs; long coff_z; const float* scale;
    __device__ void operator()(int z, int r, int n, float v) const {
        const long o = (long)z * zs + (long)r * ld + (long)z * coff_z + n;
        if (scale) v *= scale[z * coff_z + n];
        p[o] = (bf16_t)f2bf(v); } };
struct LdDftS { const float* ct; const float* st;
    __device__ bool active(int, int) const { return true; }
    __device__ float4 load4(int, int m, int s) const { const int k = m & 4095; const bool im = m >= 4096; float v[4];
#pragma unroll
        for (int j = 0; j < 4; ++j) { const int idx = (k * (s + j)) & 4095; v[j] = im ? -st[idx] : ct[idx]; }
        return make_float4(v[0], v[1], v[2], v[3]); } };
struct StoreY { float* yr; float* yi;
    __device__ void operator()(int z, int m, int n, float v) const { if (m < 4096) yr[((long)z * 4096 + m) * 1024 + n] = v; else yi[((long)z * 4096 + (m - 4096)) * 1024 + n] = v; } };
struct LdYri { const float* yr; const float* yi;
    __device__ bool active(int, int) const { return true; }
    __device__ float4 load4(int z, int r, int c) const { return c < 256 ? *(const float4*)(yr + (long)r * 1024 + z * 256 + c) : *(const float4*)(yi + (long)r * 1024 + z * 256 + c - 256); } };
struct LdDftD { const float* ct; const float* st;
    __device__ float4 load4(int, int k, int n, int) const { const int kk = k & 255; const bool s = k >= 256; float v[4];
#pragma unroll
        for (int j = 0; j < 4; ++j) { const int idx = ((kk * (n + j)) & 255) * 16; v[j] = (s ? st[idx] : ct[idx]) * (1.0f / 1024.0f); }
        return make_float4(v[0], v[1], v[2], v[3]); } };
struct LdGather { const float* p; long ld; const int* list; const int* off; const int* cnt;
    __device__ bool active(int z, int bm) const { return bm < cnt[z]; }
    __device__ float4 load4(int z, int r, int c) const { const bool ok = r < cnt[z]; const int t = list[off[z] + (ok ? r : 0)]; float4 v = *(const float4*)(p + (long)t * ld + c); const float m = ok ? 1.f : 0.f; v.x *= m; v.y *= m; v.z *= m; v.w *= m; return v; } };
struct LdRows { const float* p; long ld; const int* off; const int* cnt;
    __device__ bool active(int z, int bm) const { return bm < cnt[z]; }
    __device__ float4 load4(int z, int r, int c) const { const bool ok = r < cnt[z]; float4 v = *(const float4*)(p + (long)(off[z] + (ok ? r : 0)) * ld + c); const float m = ok ? 1.f : 0.f; v.x *= m; v.y *= m; v.z *= m; v.w *= m; return v; } };
struct LdGU { const float* wg; const float* wu;
    __device__ float4 load4(int z, int k, int n, int nl) const { const int bn = n - nl, wc = nl >> 6, t = (nl & 63) >> 4, c = nl & 15; const int f = (bn >> 1) + wc * 32 + (t & 1) * 16 + c;
        const long delta = (t < 2) ? 0l : (long)(wu - wg); return *(const float4*)(wg + delta + ((long)z * D + k) * FF + f); } };
struct EpGU { float* act; const int* off; const int* cnt; const float* pw;
    __device__ void operator()(int z, int bm, int bn, int wr, int wc, int lane, const f32x4 (&acc)[4][4]) const {
#pragma unroll
        for (int m = 0; m < 4; ++m)
#pragma unroll
            for (int t = 0; t < 2; ++t)
#pragma unroll
                for (int r = 0; r < 4; ++r) { const int row = bm + wr * 64 + m * 16 + (lane >> 4) * 4 + r; if (row >= cnt[z]) continue;
                    const int f = (bn >> 1) + wc * 32 + t * 16 + (lane & 15); const float g = acc[m][t][r], u = acc[m][t + 2][r];
                    const long pos = off[z] + row; act[pos * FF + f] = g / (1.f + __expf(-g)) * u * pw[pos]; }
    } };
struct EpDown { float* yd; const int* off; const int* cnt;
    __device__ void operator()(int z, int bm, int bn, int wr, int wc, int lane, const f32x4 (&acc)[4][4]) const {
#pragma unroll
        for (int m = 0; m < 4; ++m)
#pragma unroll
            for (int n = 0; n < 4; ++n)
#pragma unroll
                for (int r = 0; r < 4; ++r) { const int row = bm + wr * 64 + m * 16 + (lane >> 4) * 4 + r; if (row >= cnt[z]) continue;
                    yd[(long)(off[z] + row) * D + bn + wc * 64 + n * 16 + (lane & 15)] = acc[m][n][r]; }
    } };

struct Params {
    const float *x, *g_mix, *w_in, *w_pool, *pool_scale, *w_fourier, *w_out, *g_ffn, *wgr, *bgr, *wer, *ber, *w_gate, *w_up, *w_down, *g_final;
    float* out; char* ws;
};

__device__ __forceinline__ void transpose_item(const float* W, int ldw, int k0, int n0, bf16_t* dst, int dstK, LAS float* scr, int lane) {
    float tv[32];
#pragma unroll
    for (int i = 0; i < 32; ++i) tv[i] = W[(size_t)(k0 + 2 * i + (lane >> 5)) * ldw + n0 + (lane & 31)];
#pragma unroll
    for (int i = 0; i < 32; ++i) scr[(2 * i + (lane >> 5)) * 33 + (lane & 31)] = tv[i];
    asm volatile("s_waitcnt lgkmcnt(0)" ::: "memory");
    const int c = lane & 7;
#pragma unroll
    for (int j = 0; j < 4; ++j) { const int n = (lane >> 3) + 8 * j; const LAS float* sp = scr + (8 * c) * 33 + n;
        u32x4 o; o.x = pk2(sp[0 * 33], sp[1 * 33]); o.y = pk2(sp[2 * 33], sp[3 * 33]); o.z = pk2(sp[4 * 33], sp[5 * 33]); o.w = pk2(sp[6 * 33], sp[7 * 33]);
        *(u32x4*)(dst + (size_t)n * dstK + k0 + 8 * c) = o; }
    asm volatile("s_waitcnt lgkmcnt(0)" ::: "memory");
}

__device__ __forceinline__ void rms_row(const float* x, const float* g, float* outf, bf16_t* outb, int row, int lane, const bf16_t* yd, const int* tpos, f32x4 (&v)[8], const bf16_t* mb = nullptr) {
    const f32x4* xr = (const f32x4*)(x + (long)row * D) + lane; float s = 0.f;
#pragma unroll
    for (int j = 0; j < 8; ++j) v[j] = xr[64 * j];
    if (mb) { const u32x2* mr = (const u32x2*)(mb + (long)row * D) + lane;
#pragma unroll
        for (int j = 0; j < 8; ++j) { const u32x2 a = mr[64 * j]; v[j].x += __uint_as_float(a.x << 16); v[j].y += __uint_as_float(a.x & 0xffff0000u); v[j].z += __uint_as_float(a.y << 16); v[j].w += __uint_as_float(a.y & 0xffff0000u); } }
    if (yd) {
        const int p0 = tpos[2 * row], p1 = tpos[2 * row + 1];
        const u32x2* y0 = (const u32x2*)(yd + (long)p0 * D) + lane; const u32x2* y1 = (const u32x2*)(yd + (long)p1 * D) + lane;
#pragma unroll
        for (int j = 0; j < 8; ++j) { const u32x2 a = y0[64 * j], b = y1[64 * j];
            v[j].x += __uint_as_float(a.x << 16) + __uint_as_float(b.x << 16); v[j].y += __uint_as_float(a.x & 0xffff0000u) + __uint_as_float(b.x & 0xffff0000u);
            v[j].z += __uint_as_float(a.y << 16) + __uint_as_float(b.y << 16); v[j].w += __uint_as_float(a.y & 0xffff0000u) + __uint_as_float(b.y & 0xffff0000u); }
    }
#pragma unroll
    for (int j = 0; j < 8; ++j) s += (v[j].x * v[j].x + v[j].y * v[j].y) + (v[j].z * v[j].z + v[j].w * v[j].w);
    const float rstd = 1.0f / sqrtf(wave_sum(s) * (1.0f / D) + EPS);
    const f32x4* gr = (const f32x4*)g + lane;
#pragma unroll
    for (int j = 0; j < 8; ++j) v[j] = v[j] * rstd * gr[64 * j];
    if (outf) { f32x4* orow = (f32x4*)(outf + (long)row * D) + lane;
#pragma unroll
        for (int j = 0; j < 8; ++j) orow[64 * j] = v[j]; }
    if (outb) { u32x2* orow = (u32x2*)(outb + (long)row * D) + lane;
#pragma unroll
        for (int j = 0; j < 8; ++j) orow[64 * j] = (u32x2){pk2(v[j].x, v[j].y), pk2(v[j].z, v[j].w)}; }
}
__device__ __forceinline__ void router_row(const f32x4 (&v)[8], int row, int lane, const float* wgr, const float* bgr, const float* wer, const float* ber, int* tok_e, float* tok_w, int* cnt) {
    float acc[20];
#pragma unroll
    for (int j = 0; j < 20; ++j) acc[j] = 0.f;
#pragma unroll
    for (int j = 0; j < 8; ++j)
#pragma unroll
        for (int i = 0; i < 4; ++i) {
            const int d = 256 * j + 4 * lane + i; const float hv = v[j][i];
            const f32x4 wg = *(const f32x4*)(wgr + d * 4);
            acc[0] += hv * wg.x; acc[1] += hv * wg.y; acc[2] += hv * wg.z; acc[3] += hv * wg.w;
#pragma unroll
            for (int q = 0; q < 4; ++q) { const f32x4 we = *(const f32x4*)(wer + d * 16 + q * 4);
                acc[4 + q * 4 + 0] += hv * we.x; acc[4 + q * 4 + 1] += hv * we.y; acc[4 + q * 4 + 2] += hv * we.z; acc[4 + q * 4 + 3] += hv * we.w; }
        }
#pragma unroll
    for (int j = 0; j < 20; ++j) acc[j] = wave_sum(acc[j]);
    if (lane == 0) {
        float gl[4]; int gi = 0; float mx = -3.0e38f;
#pragma unroll
        for (int j = 0; j < 4; ++j) { gl[j] = acc[j] + bgr[j]; if (gl[j] > mx) { mx = gl[j]; gi = j; } }
        float se = 0.f;
#pragma unroll
        for (int j = 0; j < 4; ++j) se += __expf(gl[j] - mx);
        const float pg = 1.0f / se;
        float el[4];
#pragma unroll
        for (int j = 0; j < 4; ++j) { float t = 0.f;
#pragma unroll
            for (int q = 0; q < 4; ++q) t = (gi == q) ? acc[4 + q * 4 + j] + ber[q * 4 + j] : t;
            el[j] = t; }
        int i0 = 0; float v0 = el[0];
#pragma unroll
        for (int j = 1; j < 4; ++j) if (el[j] > v0) { v0 = el[j]; i0 = j; }
        int i1 = -1; float v1 = -3.0e38f;
#pragma unroll
        for (int j = 0; j < 4; ++j) if (j != i0 && el[j] > v1) { v1 = el[j]; i1 = j; }
        const float e1 = __expf(v1 - v0), inv = 1.0f / (1.0f + e1);
        const int ea = gi * 4 + i0, eb = gi * 4 + i1;
        tok_e[2 * row] = ea; tok_e[2 * row + 1] = eb; tok_w[2 * row] = pg * inv; tok_w[2 * row + 1] = pg * e1 * inv;
        atomicAdd(&cnt[ea], 1); atomicAdd(&cnt[eb], 1);
    }
}


typedef short s16x4 __attribute__((ext_vector_type(4)));
constexpr int DP = 544, DFT_TILE = 64 * DP, DFT_TAB_OFF = 2 * DFT_TILE;
__device__ __forceinline__ s16x4 tr16(const LAS unsigned char* p) { return __builtin_bit_cast(s16x4, __builtin_amdgcn_ds_read_tr16_b64_v4i16((LAS s16x4*)p)); }
__device__ __forceinline__ int dft_row_of_slot(int ks, int fq, int jj) { return 32 * ks + 16 * (jj >> 2) + 4 * fq + (jj & 3); }
__device__ __forceinline__ void dft_make_tables(bf16_t* t1, bf16_t* t2, int gtid, int gthreads) {
    for (int i = gtid; i < 2 * 8 * 64 * 8; i += gthreads) { const int jj = i & 7, l = (i >> 3) & 63, nt = (i >> 9) & 7, ks = i >> 12; const int fr = l & 15, fq = l >> 4;
        const int c = 16 * (nt & 3) + fr, a = dft_row_of_slot(ks, fq, jj); const float x = (float)((a * c) & 63) / 32.0f;
        t1[i] = (bf16_t)f2bf(nt < 4 ? cospif(x) : -sinpif(x)); }
    for (int i = gtid; i < 4 * 8 * 64 * 8; i += gthreads) { const int jj = i & 7, l = (i >> 3) & 63, nt = (i >> 9) & 7, ks = i >> 12; const int fr = l & 15, fq = l >> 4;
        const int d = 16 * (nt & 3) + fr, bp = dft_row_of_slot(ks & 1, fq, jj), part = ks >> 1; const float x = (float)((bp * d) & 63) / 32.0f;
        float v; if (nt < 4) v = part == 0 ? cospif(x) : sinpif(x); else v = part == 0 ? -sinpif(x) : cospif(x);
        t2[i] = (bf16_t)f2bf(v); }
}
template <int STAGE>
__device__ __forceinline__ void dft_pass(LAS unsigned char* lds, const bf16_t* src, bf16_t* dst, const bf16_t* tab, const float* ct, const float* st) {
    constexpr int NL = STAGE == 1 ? 4 : 8, NKS = STAGE == 1 ? 2 : 4;
    int tid_ = threadIdx.x; asm volatile("" : "+v"(tid_));
    const int tid = tid_, lane = tid & 63, w = __builtin_amdgcn_readfirstlane(tid >> 6), fr = lane & 15, fq = lane >> 4;
    const int G = gridDim.x, bx = blockIdx.x, vcu = (G % 8 == 0) ? (bx % 8) * (G / 8) + bx / 8 : bx;
    for (int i = tid; i < NKS * 8 * 64; i += NTHR) *(LAS u32x4*)(lds + DFT_TAB_OFF + i * 16) = *(const u32x4*)(tab + (size_t)i * 8);
    u32x4 pre[NL];
    auto unit_src = [&](int uid, int i) -> const bf16_t* {
        const int h = uid & 3, x = (uid >> 2) & 63, b = uid >> 8, idx = tid + NTHR * i, row = (idx >> 5) & 63, ch = idx & 31;
        if (STAGE == 1) return src + ((size_t)(b * SEQ + 64 * row + x)) * D + 1024 + 256 * h + ch * 8;
        const int part = idx >> 11; return src + ((((size_t)(b * 64 + x) * 2 + part) * 64 + row) * 1024) + 256 * h + ch * 8; };
    int uid = vcu;
    if (uid < 1024) {
#pragma unroll
        for (int i = 0; i < NL; ++i) pre[i] = *(const u32x4*)unit_src(uid, i); }
    for (; uid < 1024; uid += G) {
#pragma unroll
        for (int i = 0; i < NL; ++i) { const int idx = tid + NTHR * i, part = idx >> 11, row = (idx >> 5) & 63, ch = idx & 31; *(LAS u32x4*)(lds + part * DFT_TILE + row * DP + ch * 16) = pre[i]; }
        __syncthreads();
        if (uid + G < 1024) {
#pragma unroll
            for (int i = 0; i < NL; ++i) pre[i] = *(const u32x4*)unit_src(uid + G, i); }
        const int h = uid & 3, x = (uid >> 2) & 63, b = uid >> 8;
        f32x4 acc[2][8];
#pragma unroll
        for (int mt = 0; mt < 2; ++mt)
#pragma unroll
            for (int nt = 0; nt < 8; ++nt) acc[mt][nt] = (f32x4){0.f, 0.f, 0.f, 0.f};
#pragma unroll
        for (int ks = 0; ks < NKS; ++ks) {
            bf16x8 A[2];
#pragma unroll
            for (int mt = 0; mt < 2; ++mt) {
                const LAS unsigned char* base = lds + (ks >> 1) * DFT_TILE + (32 * (ks & 1) + 4 * fq + (fr >> 2)) * DP + (32 * w + 8 * (fr & 3) + 4 * mt) * 2;
                const s16x4 lo = tr16(base), hi = tr16(base + 16 * DP);
                A[mt] = (bf16x8){lo[0], lo[1], lo[2], lo[3], hi[0], hi[1], hi[2], hi[3]}; }
#pragma unroll
            for (int nt = 0; nt < 8; ++nt) { const bf16x8 B = *(const LAS bf16x8*)(lds + DFT_TAB_OFF + ((ks * 8 + nt) * 64 + lane) * 16);
#pragma unroll
                for (int mt = 0; mt < 2; ++mt) acc[mt][nt] = __builtin_amdgcn_mfma_f32_16x16x32_bf16(A[mt], B, acc[mt][nt], 0, 0, 0); }
        }
        const int colb = 256 * h + 32 * w + 8 * fq;
#pragma unroll
        for (int nt = 0; nt < 4; ++nt) {
            const int f = 16 * nt + fr; f32x4 re[2], im[2];
            if (STAGE == 1) { const int idx = (x * f) & 4095; const float cp = ct[idx], sp = st[idx];
#pragma unroll
                for (int mt = 0; mt < 2; ++mt) { re[mt] = acc[mt][nt] * cp + acc[mt][nt + 4] * sp; im[mt] = acc[mt][nt + 4] * cp - acc[mt][nt] * sp; } }
            else {
#pragma unroll
                for (int mt = 0; mt < 2; ++mt) { re[mt] = acc[mt][nt]; im[mt] = acc[mt][nt + 4]; } }
            const u32x4 vr = (u32x4){pk2(re[0][0], re[0][1]), pk2(re[0][2], re[0][3]), pk2(re[1][0], re[1][1]), pk2(re[1][2], re[1][3])};
            const u32x4 vi = (u32x4){pk2(im[0][0], im[0][1]), pk2(im[0][2], im[0][3]), pk2(im[1][0], im[1][1]), pk2(im[1][2], im[1][3])};
            if (STAGE == 1) { bf16_t* o = dst + ((((size_t)(b * 64 + f) * 2) * 64 + x) * 1024) + colb;
                *(u32x4*)o = vr; *(u32x4*)(o + (size_t)64 * 1024) = vi; }
            else { bf16_t* o = dst + ((size_t)(b * SEQ + x + 64 * f)) * D + 512 * h + 32 * w + 8 * fq;
                *(u32x4*)o = vr; *(u32x4*)(o + 256) = vi; }
        }
        __syncthreads();
    }
}
__device__ __forceinline__ void pool_pass(LAS unsigned char* lds, const bf16_t* UB, bf16_t* MIXB) {
    int tid_ = threadIdx.x; asm volatile("" : "+v"(tid_)); const int tid = tid_;
    for (int tile = blockIdx.x; tile < NTOK / 32; tile += gridDim.x) {
        const int tok0 = tile * 32, b = tok0 / SEQ, t0 = tok0 % SEQ;
        u32x4 ld[12];
#pragma unroll
        for (int i = 0; i < 12; ++i) { const int idx = tid + NTHR * i, r = idx >> 7, ch = idx & 127; const int t = t0 - 7 + r;
            ld[i] = (r < 47 && t >= 0 && t < SEQ) ? *(const u32x4*)(UB + ((size_t)(b * SEQ + t)) * D + ch * 8) : (u32x4){0u, 0u, 0u, 0u}; }
#pragma unroll
        for (int i = 0; i < 12; ++i) { const int idx = tid + NTHR * i; if (idx < 47 * 128) *(LAS u32x4*)(lds + idx * 16) = ld[i]; }
        __syncthreads();
#pragma unroll 2
        for (int it = 0; it < 8; ++it) { const int idx = tid + NTHR * it, tl = idx >> 7, ch = idx & 127, g = ch >> 5, k = 2 << g, t = t0 + tl;
            int lo = t - (k - 1) / 2, hi = t + k / 2 + 1; lo = lo < 0 ? 0 : lo; hi = hi > SEQ ? SEQ : hi;
            float sm[8];
#pragma unroll
            for (int j = 0; j < 8; ++j) sm[j] = 0.f;
            for (int tt = lo; tt < hi; ++tt) { const u32x4 v = *(const LAS u32x4*)(lds + ((tt - t0 + 7) * 128 + ch) * 16);
#pragma unroll
                for (int j = 0; j < 4; ++j) { sm[2 * j] += __uint_as_float(v[j] << 16); sm[2 * j + 1] += __uint_as_float(v[j] & 0xffff0000u); } }
            const u32x4 sv = *(const LAS u32x4*)(lds + ((tl + 7) * 128 + ch) * 16); const float inv = 1.0f / (float)(hi - lo); u32x4 o;
#pragma unroll
            for (int j = 0; j < 4; ++j) o[j] = pk2(sm[2 * j] * inv - __uint_as_float(sv[j] << 16), sm[2 * j + 1] * inv - __uint_as_float(sv[j] & 0xffff0000u));
            *(u32x4*)(MIXB + (size_t)(tok0 + tl) * D + ch * 8) = o; }
        __syncthreads();
    }
}
struct LdChanA {
    __device__ bool active(int, int) const { return true; }
    __device__ float4 load4(int, int r, int c) const { const int j = r & 255; float v[4];
#pragma unroll
        for (int q = 0; q < 4; ++q) { const float x = (float)((j * (c + q)) & 255) / 128.0f; v[q] = (r < 256 ? cospif(x) : sinpif(x)) * (1.0f / 1024.0f); }
        return make_float4(v[0], v[1], v[2], v[3]); } };
struct StoreMT { bf16_t* p;
    __device__ void operator()(int z, int r, int n, float v) const { p[((size_t)z * 256 + n) * 512 + r] = (bf16_t)f2bf(v); } };
struct StoreT { bf16_t* p; const float* scale;
    __device__ void operator()(int z, int r, int n, float v) const { p[(size_t)(z * 256 + n) * D + r] = (bf16_t)f2bf(v * scale[z * 256 + n]); } };


#define XB_TMO      128
#define XB_XCNT(j)  (256  + 64 * (j))
#define XB_XSUB(j)  (1280 + 64 * (j))
#define XB_XGEN(j)  (2304 + 64 * (j))
#define XB_TOP      3328
#define XB_TOPGEN   3392
#define XCD_BAR_WORDS 3456
#define XB_SPIN_CAP (1u << 22)
__device__ __forceinline__ unsigned xb_ld(unsigned* p)              { return __hip_atomic_load(p, __ATOMIC_RELAXED, __HIP_MEMORY_SCOPE_AGENT); }
__device__ __forceinline__ unsigned xb_add(unsigned* p, unsigned v) { return __hip_atomic_fetch_add(p, v, __ATOMIC_RELAXED, __HIP_MEMORY_SCOPE_AGENT); }
__device__ __forceinline__ unsigned xb_xcc_id() { return (unsigned)__builtin_amdgcn_s_getreg((3 << 11) | 20) & 0xFu; }
#define XB_SPIN(cond, bar) do { unsigned _sp = 0; while (cond) { __builtin_amdgcn_s_sleep(1); \
    if ((++_sp & 255u) == 0u) { if (xb_ld(&(bar)[XB_TMO])) break; if (_sp > XB_SPIN_CAP) { atomicAdd(&(bar)[XB_TMO], 1u); break; } } } } while (0)
struct XcdBarrier { unsigned* bar; unsigned x; volatile LAS unsigned* st; };
__device__ __forceinline__ XcdBarrier xcd_barrier_post(unsigned* bar, volatile LAS unsigned* st) {
    XcdBarrier b; b.bar = bar; b.x = xb_xcc_id(); b.st = st;
    if (threadIdx.x == 0) (void)xb_add(&bar[XB_XCNT(b.x)], 1u);
    return b;
}
__device__ __forceinline__ void xcd_barrier_complete(unsigned* bar, unsigned x, unsigned& nloc, unsigned& nx) {
    const unsigned G = gridDim.x * gridDim.y * gridDim.z;
    unsigned sum, cnt, mine, sp = 0u;
    for (;;) {
        sum = 0u; cnt = 0u; mine = 0u;
#pragma unroll
        for (unsigned j = 0; j < 16; ++j) { const unsigned c = xb_ld(&bar[XB_XCNT(j)]); sum += c; cnt += (c > 0u) ? 1u : 0u; mine = (j == x) ? c : mine; }
        if (sum == G) break;
        __builtin_amdgcn_s_sleep(1);
        if ((++sp & 255u) == 0u) { if (xb_ld(&bar[XB_TMO])) break; if (sp > XB_SPIN_CAP) { atomicAdd(&bar[XB_TMO], 1u); break; } }
    }
    nloc = mine > 0u ? mine : 1u; nx = cnt > 0u ? cnt : 1u;
}
__device__ __forceinline__ void xcd_barrier(const XcdBarrier& b) {
    asm volatile("s_waitcnt vmcnt(0)" ::: "memory");
    __syncthreads();
    if (threadIdx.x == 0) {
        unsigned* bar = b.bar;
        __builtin_amdgcn_s_waitcnt(0);
        unsigned nloc = b.st[0], nx = b.st[1];
        if (nloc == 0u) { xcd_barrier_complete(bar, b.x, nloc, nx); b.st[0] = nloc; b.st[1] = nx; }
        const unsigned old = xb_add(&bar[XB_XSUB(b.x)], 1u);
        const unsigned gen = old / nloc;
        if (old + 1u == (gen + 1u) * nloc) {
            __builtin_amdgcn_fence(__ATOMIC_RELEASE, "agent");
            asm volatile("s_waitcnt vmcnt(0)" ::: "memory");
            const unsigned og = xb_add(&bar[XB_TOP], 1u);
            const unsigned tg = og / nx;
            if (og + 1u == (tg + 1u) * nx) xb_add(&bar[XB_TOPGEN], 1u);
            else XB_SPIN(xb_ld(&bar[XB_TOPGEN]) == tg, bar);
            __builtin_amdgcn_fence(__ATOMIC_ACQUIRE, "agent");
            xb_add(&bar[XB_XGEN(b.x)], 1u);
            asm volatile("s_waitcnt vmcnt(0)" ::: "memory");
        } else {
            XB_SPIN(xb_ld(&bar[XB_XGEN(b.x)]) == gen, bar);
            __builtin_amdgcn_fence(__ATOMIC_ACQUIRE, "agent");
            asm volatile("s_waitcnt vmcnt(0)" ::: "memory");
        }
    }
    __syncthreads();
}


__device__ __forceinline__ void router_phase(LAS unsigned char* lds, const float* x, const bf16_t* MB, const float* g, const float* wgr, const float* bgr, const float* wer, const float* ber,
                                             bf16_t* HB, int* tok_e, float* tok_w, int* tok_rel, int* cnt) {
    int tid_ = threadIdx.x; asm volatile("" : "+v"(tid_));
    const int tid = tid_, lane = tid & 63, w = __builtin_amdgcn_readfirstlane(tid >> 6), fr = lane & 15, fq = lane >> 4;
    LAS float* part = (LAS float*)lds;
    LAS float* ssqp = (LAS float*)(lds + 65536);
    LAS float* rs = (LAS float*)(lds + 67584);
    LAS int* lcnt = (LAS int*)(lds + 67840);
    LAS int* lbase = (LAS int*)(lds + 67904);
    LAS float* W1t = (LAS float*)(lds + 69632);
    for (int i = tid; i < 4 * D; i += NTHR) { const int c = i >> 11, k = i & (D - 1); W1t[i] = g[k] * wer[k * 16 + 12 + c]; }
    float Bw[16][4];
    { const float* s0 = fr < 4 ? wgr + fr : wer + (fr - 4); const int st0 = fr < 4 ? 4 : 16;
#pragma unroll
      for (int jj = 0; jj < 16; ++jj)
#pragma unroll
        for (int e = 0; e < 4; ++e) { const int k = 256 * w + 16 * jj + 4 * fq + e; Bw[jj][e] = g[k] * s0[k * st0]; } }
    const float m1 = fr < 4 ? 1.f : 0.f;
    const volatile LAS f32x4* w1p = (const volatile LAS f32x4*)(W1t + (fr & 3) * D + 256 * w + 4 * fq);
    const f32x4 gv = *(const f32x4*)(g + tid * 4);
    __syncthreads();
    for (int t0 = blockIdx.x * 64; t0 < NTOK; t0 += gridDim.x * 64) {
        if (tid < 16) lcnt[tid] = 0;
#pragma unroll 1
        for (int grp = 0; grp < 4; ++grp) {
            const size_t ro = (size_t)(t0 + 16 * grp + fr) * D + 256 * w + 4 * fq;
            f32x4 a[16]; u32x2 mm[16];
#pragma unroll
            for (int jj = 0; jj < 16; ++jj) { a[jj] = *(const f32x4*)(x + ro + 16 * jj); mm[jj] = *(const u32x2*)(MB + ro + 16 * jj); }
            f32x4 acc0 = (f32x4){0.f, 0.f, 0.f, 0.f}, acc1 = (f32x4){0.f, 0.f, 0.f, 0.f}; float sq = 0.f;
#pragma unroll
            for (int jj = 0; jj < 16; ++jj) { f32x4 b1 = w1p[4 * jj]; b1 = b1 * m1;
                const f32x4 av4 = a[jj] + (f32x4){__uint_as_float(mm[jj].x << 16), __uint_as_float(mm[jj].x & 0xffff0000u), __uint_as_float(mm[jj].y << 16), __uint_as_float(mm[jj].y & 0xffff0000u)};
#pragma unroll
                for (int e = 0; e < 4; ++e) { const float av = av4[e]; sq += av * av;
                    acc0 = __builtin_amdgcn_mfma_f32_16x16x4f32(av, Bw[jj][e], acc0, 0, 0, 0);
                    acc1 = __builtin_amdgcn_mfma_f32_16x16x4f32(av, b1[e], acc1, 0, 0, 0); } }
            sq += __shfl_xor(sq, 16); sq += __shfl_xor(sq, 32);
#pragma unroll
            for (int r = 0; r < 4; ++r) { part[(w * 64 + 16 * grp + 4 * fq + r) * 32 + fr] = acc0[r]; part[(w * 64 + 16 * grp + 4 * fq + r) * 32 + 16 + fr] = acc1[r]; }
            if (fq == 0) ssqp[w * 64 + 16 * grp + fr] = sq;
        }
        __syncthreads();
        int ea = 0, eb = 0, ra = 0, rb = 0; float wa = 0.f, wb = 0.f;
        if (tid < 64) {
            float ss = 0.f;
#pragma unroll
            for (int q = 0; q < 8; ++q) ss += ssqp[q * 64 + tid];
            const float rstd = 1.0f / sqrtf(ss * (1.0f / D) + EPS); rs[tid] = rstd;
            float lg[20];
#pragma unroll
            for (int n = 0; n < 20; ++n) { float t = 0.f;
#pragma unroll
                for (int q = 0; q < 8; ++q) t += part[(q * 64 + tid) * 32 + n];
                lg[n] = t * rstd; }
            float gl[4]; int gi = 0; float mx = -3.0e38f;
#pragma unroll
            for (int j = 0; j < 4; ++j) { gl[j] = lg[j] + bgr[j]; if (gl[j] > mx) { mx = gl[j]; gi = j; } }
            float se = 0.f;
#pragma unroll
            for (int j = 0; j < 4; ++j) se += __expf(gl[j] - mx);
            const float pg = 1.0f / se;
            float el[4];
#pragma unroll
            for (int j = 0; j < 4; ++j) { float t = 0.f;
#pragma unroll
                for (int q = 0; q < 4; ++q) t = (gi == q) ? lg[4 + q * 4 + j] + ber[q * 4 + j] : t;
                el[j] = t; }
            int i0 = 0; float v0 = el[0];
#pragma unroll
            for (int j = 1; j < 4; ++j) if (el[j] > v0) { v0 = el[j]; i0 = j; }
            int i1 = -1; float v1 = -3.0e38f;
#pragma unroll
            for (int j = 0; j < 4; ++j) if (j != i0 && el[j] > v1) { v1 = el[j]; i1 = j; }
            const float e1 = __expf(v1 - v0), inv = 1.0f / (1.0f + e1);
            ea = gi * 4 + i0; eb = gi * 4 + i1; wa = pg * inv; wb = pg * e1 * inv;
            ra = __hip_atomic_fetch_add(&lcnt[ea], 1, __ATOMIC_RELAXED, __HIP_MEMORY_SCOPE_WORKGROUP); rb = __hip_atomic_fetch_add(&lcnt[eb], 1, __ATOMIC_RELAXED, __HIP_MEMORY_SCOPE_WORKGROUP);
        }
        __syncthreads();
        if (tid < 16) lbase[tid] = atomicAdd(&cnt[tid], lcnt[tid]);
        __syncthreads();
        if (tid < 64) { const int row = t0 + tid;
            tok_e[2 * row] = ea; tok_e[2 * row + 1] = eb; tok_w[2 * row] = wa; tok_w[2 * row + 1] = wb;
            tok_rel[2 * row] = lbase[ea] + ra; tok_rel[2 * row + 1] = lbase[eb] + rb; }
#pragma unroll 1
        for (int bt = 0; bt < 4; ++bt) { f32x4 xv[16]; u32x2 mv[16];
#pragma unroll
            for (int j = 0; j < 16; ++j) { const size_t o = (size_t)(t0 + 16 * bt + j) * D + tid * 4; xv[j] = *(const f32x4*)(x + o); mv[j] = *(const u32x2*)(MB + o); }
#pragma unroll
            for (int j = 0; j < 16; ++j) { const float r = rs[16 * bt + j];
                const f32x4 xs = xv[j] + (f32x4){__uint_as_float(mv[j].x << 16), __uint_as_float(mv[j].x & 0xffff0000u), __uint_as_float(mv[j].y << 16), __uint_as_float(mv[j].y & 0xffff0000u)};
                *(u32x2*)(HB + (size_t)(t0 + 16 * bt + j) * D + tid * 4) = (u32x2){pk2(xs[0] * r * gv[0], xs[1] * r * gv[1]), pk2(xs[2] * r * gv[2], xs[3] * r * gv[3])}; } }
        __syncthreads();
    }
}

struct TI { int tid, lane, wid, gtid, gwave; };
__device__ __forceinline__ TI ti() { int t = threadIdx.x; asm volatile("" : "+v"(t)); TI r; r.tid = t; r.lane = t & 63; r.wid = t >> 6; r.gtid = blockIdx.x * NTHR + t; r.gwave = blockIdx.x * NWAVE + (t >> 6); return r; }

__global__ __launch_bounds__(NTHR, 2) void mega(Params p) {
    extern __shared__ __attribute__((aligned(16))) unsigned char lds_raw[];
    LAS unsigned char* lds = (LAS unsigned char*)lds_raw;
    lds_tile_t As = (lds_tile_t)(lds); lds_tile_t Bs = (lds_tile_t)(lds + 256 * 40 * 2);
    cg::grid_group grid = cg::this_grid();
    { volatile LAS unsigned* stw = (volatile LAS unsigned*)(lds + LDS_BYTES - 16); if (threadIdx.x < 4) stw[threadIdx.x] = 0u; }
    __syncthreads();
    const XcdBarrier xbar = xcd_barrier_post((unsigned*)(p.ws + BAR_OFF), (volatile LAS unsigned*)(lds + LDS_BYTES - 16));
    if (p.ws == nullptr) grid.sync();
#if PROBE
    unsigned long long* ts = (unsigned long long*)(p.ws + 83 * MiB); int nstamp = 0;
#define STAMP() do { if (blockIdx.x == 0 && threadIdx.x == 0) ts[nstamp] = __builtin_amdgcn_s_memrealtime(); ++nstamp; } while (0)
    STAMP();
#define GSYNC() do { xcd_barrier(xbar); STAMP(); } while (0)
#else
#define GSYNC() xcd_barrier(xbar)
#endif
    const int gthreads = gridDim.x * NTHR, gwaves = gridDim.x * NWAVE;
    char* ws = p.ws; float* out = p.out;
    bf16_t* HB = (bf16_t*)(ws + 0 * MiB);
    bf16_t* WTIN = (bf16_t*)(ws + 64 * MiB);
    bf16_t* WTOUT = (bf16_t*)(ws + 72 * MiB);
    char* sm = ws + 80 * MiB;
    bf16_t* MT = (bf16_t*)(ws + 84 * MiB);
    bf16_t* WGU = (bf16_t*)(ws + 96 * MiB);
    bf16_t* WDN = (bf16_t*)(ws + 160 * MiB);
    bf16_t* UB = (bf16_t*)(ws + 192 * MiB);
    bf16_t* B1 = (bf16_t*)(ws + 256 * MiB);
    bf16_t* YA = (bf16_t*)(ws + 320 * MiB);
    bf16_t* MIXB = (bf16_t*)(ws + 384 * MiB);
    bf16_t* MB = (bf16_t*)(ws + 448 * MiB);
    bf16_t* YD = (bf16_t*)(ws + 192 * MiB);
    bf16_t* ACT = (bf16_t*)(ws + 320 * MiB);
    float* ct = (float*)(sm); float* st = (float*)(sm + 16384);
    int* cnt = (int*)(sm + 32768); int* off = cnt + 64; int* cur = cnt + 128;
    int* tok_e = (int*)(sm + 65536); float* tok_w = (float*)(sm + 65536 + 131072);
    int* list = (int*)(sm + 65536 + 2 * 131072); int* tpos = (int*)(sm + 65536 + 3 * 131072); float* pw = (float*)(sm + 65536 + 4 * 131072); int* tok_rel = (int*)(sm + 65536 + 5 * 131072);
    bf16_t* TAB1 = (bf16_t*)(sm + 1 * MiB); bf16_t* TAB2 = (bf16_t*)(sm + 1 * MiB + 32768);
    LAS unsigned* rowtab = (LAS unsigned*)(lds + 131072);
    f32x4 v[8];

    { const TI T = ti(); const int tid = T.tid, lane = T.lane, wid = T.wid, gtid = T.gtid, gwave = T.gwave; (void)tid; (void)lane; (void)wid; (void)gtid; (void)gwave;
    for (int i = gtid; i < 4096; i += gthreads) { ct[i] = cospif((float)i / 2048.0f); st[i] = sinpif((float)i / 2048.0f); }
    if (gtid < 192) cnt[gtid] = 0;
    dft_make_tables(TAB1, TAB2, gtid, gthreads);
    { LdChanA a; LdB b{p.w_fourier, GD, (long)GD * GD, 0}; EpEl<StoreMT> e{{MT}};
      sgemm_phase(a, b, e, GD, GD / 128, 512 / 256, 4, As, Bs); }
    { LdA a{p.w_in, D, 0, GD}; LdB b{p.w_pool, GD, (long)GD * GD, 0}; EpEl<StoreT> e{{WTIN, p.pool_scale}};
      sgemm_phase(a, b, e, GD, GD / 128, D / 256, 4, As, Bs); }
    { LAS float* scr = (LAS float*)(lds + wid * 16384);
      constexpr int I_WI = (D / 64) * (FW / 32), I_W = (D / 64) * (D / 32), I_E = 512, NIT = I_WI + I_W + NE * 3 * I_E;
      for (int it = gwave; it < NIT; it += gwaves) {
          if (it < I_WI) { const int n0 = 1024 + 32 * (it % 32); transpose_item(p.w_in, D, 64 * (it / 32), n0, WTIN + (size_t)n0 * D, D, scr, lane); continue; }
          if (it < I_WI + I_W) { const int r = it - I_WI; transpose_item(p.w_out, D, 64 * (r / 64), 32 * (r % 64), WTOUT + (size_t)(32 * (r % 64)) * D, D, scr, lane); continue; }
          const int r = it - I_WI - I_W, e = r / (3 * I_E), q = (r % (3 * I_E)) / I_E, j = r % I_E;
          if (q < 2) { const int k0 = 64 * (j / 16), n0 = 32 * (j % 16); const float* W = (q == 0 ? p.w_gate : p.w_up) + (size_t)e * D * FF;
              transpose_item(W, FF, k0, n0, WGU + ((size_t)e * 1024 + (n0 >> 7) * 256 + (n0 & 127) + q * 128) * D, D, scr, lane); }
          else { const int k0 = 64 * (j / 64), n0 = 32 * (j % 64);
              transpose_item(p.w_down + (size_t)e * FF * D, D, k0, n0, WDN + ((size_t)e * D + n0) * FF, FF, scr, lane); }
      } }
    for (int row = gwave; row < NTOK; row += gwaves) rms_row(p.x, p.g_mix, nullptr, HB, row, lane, nullptr, nullptr, v);
    }
    GSYNC();
    { const TI T = ti(); const int tid = T.tid, lane = T.lane, wid = T.wid, gtid = T.gtid, gwave = T.gwave; (void)tid; (void)lane; (void)wid; (void)gtid; (void)gwave;
    { PolBf16 S; S.init(NTOK / 256, D / 256, gridDim.x, blockIdx.x); S.K = D; S.A = HB; S.Bt = WTIN; S.C = UB; S.lda_b = D * 2; S.acol_b = 0; S.ldc = D; S.ccol0 = 0;
      pg8::gemm_phase(lds, S); }
    }
    GSYNC();
    { const TI T = ti(); const int tid = T.tid, lane = T.lane, wid = T.wid, gtid = T.gtid, gwave = T.gwave; (void)tid; (void)lane; (void)wid; (void)gtid; (void)gwave;
    dft_pass<1>(lds, UB, B1, TAB1, ct, st);
    pool_pass(lds, UB, MIXB);
    }
    GSYNC();
    { const TI T = ti(); const int tid = T.tid, lane = T.lane, wid = T.wid, gtid = T.gtid, gwave = T.gwave; (void)tid; (void)lane; (void)wid; (void)gtid; (void)gwave;
    dft_pass<2>(lds, B1, YA, TAB2, ct, st);
    }
    GSYNC();
    { const TI T = ti(); const int tid = T.tid, lane = T.lane, wid = T.wid, gtid = T.gtid, gwave = T.gwave; (void)tid; (void)lane; (void)wid; (void)gtid; (void)gwave;
    { PolBf16 S; S.init(NTOK / 256, 4, gridDim.x, blockIdx.x); S.K = 512; S.A = YA; S.Bt = MT; S.C = MIXB; S.lda_b = D * 2; S.acol_b = 1024; S.ldc = D; S.ccol0 = 1024;
      pg8::gemm_phase(lds, S); }
    }
    GSYNC();
    { const TI T = ti(); const int tid = T.tid, lane = T.lane, wid = T.wid, gtid = T.gtid, gwave = T.gwave; (void)tid; (void)lane; (void)wid; (void)gtid; (void)gwave;
    { PolBf16 S; S.init(NTOK / 256, D / 256, gridDim.x, blockIdx.x); S.K = D; S.A = MIXB; S.Bt = WTOUT; S.C = MB; S.lda_b = D * 2; S.acol_b = 0; S.ldc = D; S.ccol0 = 0;
      pg8::gemm_phase(lds, S); }
    }
    GSYNC();
    { const TI T = ti(); const int tid = T.tid, lane = T.lane, wid = T.wid, gtid = T.gtid, gwave = T.gwave; (void)tid; (void)lane; (void)wid; (void)gtid; (void)gwave;
    router_phase(lds, p.x, MB, p.g_ffn, p.wgr, p.bgr, p.wer, p.ber, HB, tok_e, tok_w, tok_rel, cnt);
    }
    GSYNC();
    { const TI T = ti(); const int tid = T.tid, lane = T.lane, wid = T.wid, gtid = T.gtid, gwave = T.gwave; (void)tid; (void)lane; (void)wid; (void)gtid; (void)gwave;
    { int offl[NE]; int s = 0;
#pragma unroll
      for (int e = 0; e < NE; ++e) { offl[e] = s; s += cnt[e]; }
      for (int i = gtid; i < 2 * NTOK; i += gthreads) {
          const int e = tok_e[i]; int o = 0;
#pragma unroll
          for (int q = 0; q < NE; ++q) o = (q == e) ? offl[q] : o;
          const int pos = o + tok_rel[i];
          list[pos] = i >> 1; tpos[i] = pos; pw[pos] = tok_w[i]; } }
    }
    GSYNC();
    { const TI T = ti(); const int tid = T.tid, lane = T.lane, wid = T.wid, gtid = T.gtid, gwave = T.gwave; (void)tid; (void)lane; (void)wid; (void)gtid; (void)gwave;
    { PolMoeUp S; S.init(4, gridDim.x, blockIdx.x, cnt); S.K = D; S.A = HB; S.Bt = WGU; S.ACT = ACT; S.pw = pw; S.rowtab = rowtab;
      pg8::Unit u;
      for (int i = 0; i < 8; ++i) { if (!S.next(i, u)) break;
          if (tid < 256) { const int rr = tid < u.nrows ? tid : u.nrows - 1; rowtab[i * 256 + tid] = (unsigned)list[u.rowbase + rr] * (unsigned)(D * 2); } }
      __syncthreads();
      pg8::gemm_phase(lds, S); }
    }
    GSYNC();
    { const TI T = ti(); const int tid = T.tid, lane = T.lane, wid = T.wid, gtid = T.gtid, gwave = T.gwave; (void)tid; (void)lane; (void)wid; (void)gtid; (void)gwave;
    { PolMoeDown S; S.init(8, gridDim.x, blockIdx.x, cnt); S.K = FF; S.A = ACT; S.Bt = WDN; S.YD = YD;
      pg8::gemm_phase(lds, S); }
    }
    GSYNC();
    { const TI T = ti(); const int tid = T.tid, lane = T.lane, wid = T.wid, gtid = T.gtid, gwave = T.gwave; (void)tid; (void)lane; (void)wid; (void)gtid; (void)gwave;
    for (int row = gwave; row < NTOK; row += gwaves) rms_row(p.x, p.g_final, out, nullptr, row, lane, YD, tpos, v, MB);
    }
#if PROBE
    GSYNC();
    if (blockIdx.x == 0) {
        asm volatile("s_waitcnt vmcnt(0)" ::: "memory"); __syncthreads();
        const unsigned long long dA = ts[PROBE_A + 1] - ts[PROBE_A], dB = ts[PROBE_B + 1] - ts[PROBE_B], dC = ts[PROBE_C + 1] - ts[PROBE_C];
        if (threadIdx.x == 0) { out[0] = (float)dB * 0.005f;
            const unsigned long long t0 = __builtin_amdgcn_s_memrealtime(); while (__builtin_amdgcn_s_memrealtime() - t0 < 8ull * dA) __builtin_amdgcn_s_sleep(8); }
        if (threadIdx.x >= 64 && threadIdx.x < 464) out[threadIdx.x] = (float)dC * 0.0005f;
    }
#endif
}

extern "C" void kernel_launch(void* const* d_in, const int* in_sizes, int n_in, void* d_out, int out_size, void* d_ws, size_t ws_size, hipStream_t stream) {
    static int grid_blocks = 0;
    if (!grid_blocks) {
        int dev = 0, cus = 0, per_cu = 0;
        (void)hipGetDevice(&dev);
        (void)hipDeviceGetAttribute(&cus, hipDeviceAttributeMultiprocessorCount, dev);
        (void)hipFuncSetAttribute((const void*)mega, hipFuncAttributeMaxDynamicSharedMemorySize, LDS_BYTES);
        (void)hipOccupancyMaxActiveBlocksPerMultiprocessor(&per_cu, mega, NTHR, LDS_BYTES);
        if (per_cu > 1) per_cu = 1;
        grid_blocks = cus * per_cu;
    }
    if (ws_size < 512 * MiB || grid_blocks <= 0) { fprintf(stderr, "workspace too small or no occupancy\n"); return; }
    (void)hipMemsetAsync((char*)d_ws + BAR_OFF, 0, 16384, stream);
    Params p{};
    p.x = (const float*)d_in[0]; p.g_mix = (const float*)d_in[1]; p.w_in = (const float*)d_in[2]; p.w_pool = (const float*)d_in[3];
    p.pool_scale = (const float*)d_in[4]; p.w_fourier = (const float*)d_in[5]; p.w_out = (const float*)d_in[6]; p.g_ffn = (const float*)d_in[7];
    p.wgr = (const float*)d_in[8]; p.bgr = (const float*)d_in[9]; p.wer = (const float*)d_in[10]; p.ber = (const float*)d_in[11];
    p.w_gate = (const float*)d_in[12]; p.w_up = (const float*)d_in[13]; p.w_down = (const float*)d_in[14]; p.g_final = (const float*)d_in[15];
    p.out = (float*)d_out; p.ws = (char*)d_ws;
    void* args[] = {&p};
    hipError_t e = hipLaunchCooperativeKernel((void*)mega, dim3(grid_blocks), dim3(NTHR), args, LDS_BYTES, stream);
    if (e != hipSuccess) fprintf(stderr, "cooperative launch failed: %s (grid %d)\n", hipGetErrorString(e), grid_blocks);
}
```
